# Optimizing an MI355X kernel written in HIP

```python
import jax, jax.numpy as jnp
from jax import lax
import numpy as np

D_MODEL = 2048
BATCH = 4
SEQ = 2048
DEPTH = 1
DEC_BATCH = 16
DEC_SEQ = 32
PAST_LEN = 2048

CHUNK = 64
Q_BLOCK = 128
ROPE_THETA = 500000.0
EPS = 1e-6

A_HEADS = 8
A_KV_HEADS = 2
A_HEAD_DIM = 128
A_ROT = A_HEAD_DIM // 4
A_WIDTH = A_HEADS * A_HEAD_DIM
IDX_HEADS = 16
IDX_DIM = 64
IDX_ROT = IDX_DIM // 4
TOPK_MAX = 256

B_HEADS = 8
Q_LORA = 512
KV_LORA = 512
NOPE_DIM = 128
ROPE_DIM = 64
V_DIM = 128
B_WIDTH = B_HEADS * V_DIM

SPLIT_SIZES = (A_WIDTH, A_KV_HEADS * A_HEAD_DIM, A_KV_HEADS * A_HEAD_DIM, A_WIDTH,
               IDX_HEADS * IDX_DIM, IDX_DIM, IDX_HEADS,
               Q_LORA, KV_LORA, ROPE_DIM, B_WIDTH, 2 * D_MODEL)
PROJ_WIDTH = sum(SPLIT_SIZES)

kernel_name = 'dsa_mla_gated_hybrid_stream_step'


def rmsnorm(x, g):
    xf = x.astype(jnp.float32)
    xf = xf * lax.rsqrt(jnp.mean(xf * xf, axis=-1, keepdims=True) + EPS)
    return xf.astype(x.dtype) * g


def rope(x, pos, rot):
    half = rot // 2
    inv_freq = ROPE_THETA ** (-jnp.arange(half, dtype=jnp.float32) * (2.0 / rot))
    ang = pos.astype(jnp.float32)[:, None] * inv_freq[None, :]
    cos = jnp.cos(ang)[:, None, :]
    sin = jnp.sin(ang)[:, None, :]
    x1 = x[..., :half].astype(jnp.float32)
    x2 = x[..., half:rot].astype(jnp.float32)
    r = jnp.concatenate([x1 * cos - x2 * sin, x2 * cos + x1 * sin], axis=-1).astype(x.dtype)
    return jnp.concatenate([r, x[..., rot:]], axis=-1)


def split_proj(z):
    parts, off = [], 0
    for s in SPLIT_SIZES:
        parts.append(z[..., off:off + s])
        off += s
    return parts


def sweep_blocks(fn, qpos, *qs):
    T = qpos.shape[0]
    bs = min(T, Q_BLOCK)
    nb = T // bs
    def blk(a):
        return jnp.moveaxis(a.reshape((a.shape[0], nb, bs) + a.shape[2:]), 1, 0)
    out = lax.map(lambda args: fn(*args), (qpos.reshape(nb, bs),) + tuple(blk(a) for a in qs))
    out = jnp.moveaxis(out, 0, 1)
    return out.reshape((out.shape[0], T) + out.shape[3:])


def dsa_attend(q, k, v, iq, ik, iw, qpos, kpos):
    L = k.shape[1]
    topk = min(TOPK_MAX, L // 4)
    grp = A_HEADS // A_KV_HEADS
    kchunk = kpos // CHUNK
    ikf = ik.astype(jnp.float32)

    def block(qp, qb, iqb, iwb):
        B, Tb = qb.shape[0], qb.shape[1]
        qchunk = qp // CHUNK
        allowed = kchunk[None, :] <= qchunk[:, None]
        rel = jax.nn.relu(jnp.einsum('bthd,bsd->bths', iqb.astype(jnp.float32), ikf) * IDX_DIM ** -0.5)
        score = jnp.einsum('bths,bth->bts', rel, iwb.astype(jnp.float32))
        score = jnp.where(allowed[None], score, -jnp.inf)
        _, sel = lax.top_k(score, topk)
        valid = kchunk[sel] <= qchunk[None, :, None]
        ks = jax.vmap(lambda kk, ii: kk[ii])(k, sel)
        vs = jax.vmap(lambda vv, ii: vv[ii])(v, sel)
        qg = qb.reshape(B, Tb, A_KV_HEADS, grp, A_HEAD_DIM)
        s = jnp.einsum('btkgd,btskd->btkgs', qg, ks).astype(jnp.float32) * A_HEAD_DIM ** -0.5
        s = jnp.where(valid[:, :, None, None, :], s, -jnp.inf)
        p = jax.nn.softmax(s, axis=-1).astype(vs.dtype)
        o = jnp.einsum('btkgs,btskd->btkgd', p, vs)
        return o.reshape(B, Tb, A_WIDTH)

    return sweep_blocks(block, qpos, q, iq, iw)


def mla_attend(q_nope, q_rope, ckv, krope, w_uk, w_uv, qpos, kpos):
    k_nope = jnp.einsum('bsc,chd->bshd', ckv, w_uk)
    v = jnp.einsum('bsc,chd->bshd', ckv, w_uv)
    kchunk = kpos // CHUNK
    scale = (NOPE_DIM + ROPE_DIM) ** -0.5

    def block(qp, qn, qr):
        B, Tb = qn.shape[0], qn.shape[1]
        allowed = kchunk[None, :] <= (qp // CHUNK)[:, None]
        s = (jnp.einsum('bthd,bshd->bhts', qn, k_nope)
             + jnp.einsum('bthr,bsr->bhts', qr, krope)).astype(jnp.float32) * scale
        s = jnp.where(allowed[None, None], s, -jnp.inf)
        p = jax.nn.softmax(s, axis=-1).astype(v.dtype)
        o = jnp.einsum('bhts,bshd->bthd', p, v)
        return o.reshape(B, Tb, B_WIDTH)

    return sweep_blocks(block, qpos, q_nope, q_rope)


def layer(h, qpos, past, norm_g, w_in, w_uq, q_norm_g, kv_norm_g, w_uk, w_uv, w_o_a, w_o_b, w_out):
    B, T, _ = h.shape
    pk, pv, pik, pckv, pkr = past
    L = pk.shape[1] + T
    kpos = jnp.arange(L, dtype=jnp.int32)
    xn = rmsnorm(h, norm_g)
    aq, ak, av, agate, iq, ik, iw, cq, ckv, kr, bgate, mg = split_proj(xn @ w_in)
    aq = rope(aq.reshape(B, T, A_HEADS, A_HEAD_DIM), qpos, A_ROT)
    ak = rope(ak.reshape(B, T, A_KV_HEADS, A_HEAD_DIM), qpos, A_ROT)
    av = av.reshape(B, T, A_KV_HEADS, A_HEAD_DIM)
    iq = rope(iq.reshape(B, T, IDX_HEADS, IDX_DIM), qpos, IDX_ROT)
    ik = rope(ik[:, :, None, :], qpos, IDX_ROT)[:, :, 0, :]
    iw = iw * IDX_HEADS ** -0.5
    o_a = dsa_attend(aq, jnp.concatenate([pk, ak], axis=1), jnp.concatenate([pv, av], axis=1),
                     iq, jnp.concatenate([pik, ik], axis=1), iw, qpos, kpos)
    y_a = (o_a * jax.nn.silu(agate)) @ w_o_a
    cq = rmsnorm(cq, q_norm_g)
    qb = jnp.einsum('btc,chd->bthd', cq, w_uq)
    q_nope = qb[..., :NOPE_DIM]
    q_rope = rope(qb[..., NOPE_DIM:], qpos, ROPE_DIM)
    ckv = rmsnorm(ckv, kv_norm_g)
    kr = rope(kr[:, :, None, :], qpos, ROPE_DIM)[:, :, 0, :]
    o_b = mla_attend(q_nope, q_rope, jnp.concatenate([pckv, ckv], axis=1),
                     jnp.concatenate([pkr, kr], axis=1), w_uk, w_uv, qpos, kpos)
    y_b = (o_b * jax.nn.silu(bgate)) @ w_o_b
    g = jax.nn.sigmoid(mg.astype(jnp.float32)).astype(h.dtype)
    m = g[..., :D_MODEL] * y_a + g[..., D_MODEL:] * y_b
    h = h + m @ w_out
    return h, (ak, av, ik, ckv, kr)


def trunk(x, caches, final_g, params):
    past_len = caches[0].shape[2]
    qpos = past_len + jnp.arange(x.shape[1], dtype=jnp.int32)
    h = x
    new = []
    for l in range(DEPTH):
        h, rows = layer(h, qpos, tuple(c[l] for c in caches), *(p[l] for p in params))
        new.append(rows)
    y = rmsnorm(h, final_g)
    stacked = [jnp.stack([r[i] for r in new], axis=0) for i in range(5)]
    return y, stacked


def setup_inputs(seed: int = 0) -> dict:
    key = jax.random.key(seed)
    ks = jax.random.split(key, 20)
    f32 = jnp.float32
    nrm = lambda k, shape, s: jax.random.normal(k, shape, f32) * s
    return {
        'x_prompt': nrm(ks[0], (BATCH, SEQ, D_MODEL), 1.0),
        'x_sample': nrm(ks[1], (DEC_BATCH, DEC_SEQ, D_MODEL), 1.0),
        'cache_a_k': nrm(ks[2], (DEPTH, DEC_BATCH, PAST_LEN, A_KV_HEADS, A_HEAD_DIM), 1.0),
        'cache_a_v': nrm(ks[3], (DEPTH, DEC_BATCH, PAST_LEN, A_KV_HEADS, A_HEAD_DIM), 1.0),
        'cache_idx_k': nrm(ks[4], (DEPTH, DEC_BATCH, PAST_LEN, IDX_DIM), 1.0),
        'cache_mla_ckv': nrm(ks[5], (DEPTH, DEC_BATCH, PAST_LEN, KV_LORA), 1.0),
        'cache_mla_krope': nrm(ks[6], (DEPTH, DEC_BATCH, PAST_LEN, ROPE_DIM), 1.0),
        'norm_g': 1.0 + nrm(ks[7], (DEPTH, D_MODEL), 0.01),
        'w_in': nrm(ks[8], (DEPTH, D_MODEL, PROJ_WIDTH), D_MODEL ** -0.5),
        'w_uq': nrm(ks[9], (DEPTH, Q_LORA, B_HEADS, NOPE_DIM + ROPE_DIM), Q_LORA ** -0.5),
        'q_norm_g': 1.0 + nrm(ks[10], (DEPTH, Q_LORA), 0.01),
        'kv_norm_g': 1.0 + nrm(ks[11], (DEPTH, KV_LORA), 0.01),
        'w_uk': nrm(ks[12], (DEPTH, KV_LORA, B_HEADS, NOPE_DIM), KV_LORA ** -0.5),
        'w_uv': nrm(ks[13], (DEPTH, KV_LORA, B_HEADS, V_DIM), KV_LORA ** -0.5),
        'w_o_a': nrm(ks[14], (DEPTH, A_WIDTH, D_MODEL), A_WIDTH ** -0.5),
        'w_o_b': nrm(ks[15], (DEPTH, B_WIDTH, D_MODEL), B_WIDTH ** -0.5),
        'w_out': nrm(ks[16], (DEPTH, D_MODEL, D_MODEL), D_MODEL ** -0.5),
        'final_g': 1.0 + nrm(ks[17], (D_MODEL,), 0.01),
    }


def reference(x_prompt, x_sample, cache_a_k, cache_a_v, cache_idx_k, cache_mla_ckv, cache_mla_krope,
              norm_g, w_in, w_uq, q_norm_g, kv_norm_g, w_uk, w_uv, w_o_a, w_o_b, w_out, final_g):
    params = (norm_g, w_in, w_uq, q_norm_g, kv_norm_g, w_uk, w_uv, w_o_a, w_o_b, w_out)
    dt = x_prompt.dtype
    empty = (jnp.zeros((DEPTH, x_prompt.shape[0], 0, A_KV_HEADS, A_HEAD_DIM), dt),
             jnp.zeros((DEPTH, x_prompt.shape[0], 0, A_KV_HEADS, A_HEAD_DIM), dt),
             jnp.zeros((DEPTH, x_prompt.shape[0], 0, IDX_DIM), dt),
             jnp.zeros((DEPTH, x_prompt.shape[0], 0, KV_LORA), dt),
             jnp.zeros((DEPTH, x_prompt.shape[0], 0, ROPE_DIM), dt))
    y_prompt, (pk, pv, pik, pckv, pkr) = trunk(x_prompt, empty, final_g, params)
    caches = (cache_a_k, cache_a_v, cache_idx_k, cache_mla_ckv, cache_mla_krope)
    y_sample, (sk, sv, sik, sckv, skr) = trunk(x_sample, caches, final_g, params)
    return (y_prompt, y_sample, pk, pv, pik, pckv, pkr, sk, sv, sik, sckv, skr)
```

```cpp
#define MK_N_LAUNCHES 1
#include <hip/hip_runtime.h>
#include <cstdio>
#include <cstdint>
namespace pg8 {
#define PG8_LAS __attribute__((address_space(3)))
typedef unsigned short bf16_t;
typedef short bf16x8 __attribute__((ext_vector_type(8)));
typedef float f32x4 __attribute__((ext_vector_type(4)));
typedef unsigned u32x4 __attribute__((ext_vector_type(4)));
constexpr int BM = 256, BK = 64, HALF = 128, HTB = HALF * BK * 2  , STAGE_BYTES = 8 * HTB, NXCD = 8, WGM = 8;

__host__ __device__ __forceinline__ int lds_byte(int r, int c) { const int st = (r >> 4) * 2 + (c >> 5), rr = r & 15, cc = c & 31, ob = rr * 64 + cc * 2; return st * 1024 + (ob ^ (((ob >> 9) & 1) << 5)); }
__host__ __device__ __forceinline__ void stage_rc(int b, int& R, int& C) { const int st = b / 1024, sb = b % 1024, swz = sb ^ (((sb >> 9) & 1) << 5); R = (st >> 1) * 16 + swz / 64; C = (st & 1) * 32 + (swz % 64) / 2; }
__host__ __device__ __forceinline__ int perm32(int rho) { const int n = rho >> 4, i = rho & 15; return 8 * (i >> 2) + 4 * n + (i & 3); }

struct Unit { int pm, pn; };
struct Gemm { const bf16_t* A; const bf16_t* Bt; int M, N, K; };

struct StaticOrder {
    int nM, nN, nwg, G, c;
    __host__ __device__ void init(int M, int N, int G_, int c_) { nM = M / BM; nN = N / BM; nwg = nM * nN; G = G_; c = c_; }
    __host__ __device__ bool next(int i, Unit& u) const {
        const long L = (long)i * G + c; if (L >= nwg) return false;
        int wgid = (int)L; { const int q = nwg / NXCD, r = nwg % NXCD, xcd = wgid % NXCD, off = wgid / NXCD; wgid = (xcd < r ? xcd * (q + 1) : r * (q + 1) + (xcd - r) * q) + off; }
        const int nig = WGM * nN, gid = wgid / nig, fm = gid * WGM, gsz = (nM - fm) < WGM ? (nM - fm) : WGM;
        u.pm = fm + ((wgid % nig) % gsz); u.pn = (wgid % nig) / gsz; return true;
    }
    __device__ __forceinline__ void a_ready(const Unit&) const {}
    __device__ __forceinline__ void done(const Unit&) const {}
};

__device__ __forceinline__ unsigned cvt_pk_bf16(float lo, float hi) { unsigned r; asm volatile("v_cvt_pk_bf16_f32 %0, %1, %2" : "=v"(r) : "v"(lo), "v"(hi)); return r; }
typedef float f32x2 __attribute__((ext_vector_type(2)));
template <class Epi, class Sched, bool ALIGN_EPI = false, bool SP2 = false>
__device__ __forceinline__ void gemm_phase(PG8_LAS unsigned char* lds, const Gemm g, const Sched& S, const Epi& E) {
    const int tid = threadIdx.x, wid = __builtin_amdgcn_readfirstlane(tid >> 6), lane = tid & 63, wr = wid >> 2, wc = wid & 3, fr = lane & 15, fq = lane >> 4;
    const int K = g.K, nt = K / BK;
    unsigned voffA[2], voffB[2];
#pragma unroll
    for (int i = 0; i < 2; ++i) { int R, C; stage_rc(tid * 16 + i * 8192, R, C); const int Rb = Epi::PERM ? ((R & ~31) + perm32(R & 31)) : R;
        voffA[i] = (unsigned)(R * K + C) * 2u; voffB[i] = (unsigned)(Rb * K + C) * 2u; }
    const size_t kstep = (size_t)(BK * 2);
    const size_t hstep = (size_t)HALF * K * 2;
    const size_t tstep = 2 * hstep;
    const unsigned ldsw = (unsigned)wid * 1024u;
    const int aoff = lds_byte(wr * 64 + fr, fq * 8), boff = lds_byte(wc * 32 + fr, fq * 8);
#define PG8_SA(b, h) (((b) * 2 + (h)) * HTB)
#define PG8_SB(b, h) ((4 + (b) * 2 + (h)) * HTB)
#define PG8_STAGE(bufoff, gbase, voff) do { _Pragma("unroll") for (int _i = 0; _i < 2; ++_i) \
        __builtin_amdgcn_global_load_lds((const unsigned*)((const char*)(gbase) + (voff)[_i]), (PG8_LAS unsigned*)(lds + (bufoff) + ldsw + _i * 8192), 16, 0, 0); } while (0)
#define PG8_LDA(dst, b, h) do { _Pragma("unroll") for (int m = 0; m < 4; ++m) _Pragma("unroll") for (int k = 0; k < 2; ++k) dst[m][k] = *(const PG8_LAS bf16x8*)(lds + PG8_SA(b, h) + aoff + m * 2048 + k * 1024); } while (0)
#define PG8_LDB(dst, b, h) do { _Pragma("unroll") for (int n = 0; n < 2; ++n) _Pragma("unroll") for (int k = 0; k < 2; ++k) dst[n][k] = *(const PG8_LAS bf16x8*)(lds + PG8_SB(b, h) + boff + n * 2048 + k * 1024); } while (0)
#define PG8_MMA(ai, bj, At, Bt) do { __builtin_amdgcn_s_setprio(1); _Pragma("unroll") for (int m = 0; m < 4; ++m) _Pragma("unroll") for (int n = 0; n < 2; ++n) _Pragma("unroll") for (int k = 0; k < 2; ++k) \
        acc[ai][bj][m][n] = __builtin_amdgcn_mfma_f32_16x16x32_bf16(Bt[n][k], At[m][k], acc[ai][bj][m][n], 0, 0, 0); __builtin_amdgcn_s_setprio(0); } while (0)
#define PG8_WAIT_V(n) asm volatile("s_waitcnt vmcnt(" #n ")" ::: "memory")
#define PG8_WAIT_L(n) asm volatile("s_waitcnt lgkmcnt(" #n ")" ::: "memory")
#define PG8_BAR __builtin_amdgcn_s_barrier()
#define PG8_SCHED __builtin_amdgcn_sched_barrier(0)
    Unit cur, nxt; int ui = 0;
    if (!S.next(0, cur)) return;
    f32x4 acc[2][2][4][2];
#pragma unroll
    for (int a = 0; a < 2; ++a)
#pragma unroll
        for (int b = 0; b < 2; ++b)
#pragma unroll
            for (int m = 0; m < 4; ++m)
#pragma unroll
                for (int n = 0; n < 2; ++n) acc[a][b][m][n] = (f32x4){0.f, 0.f, 0.f, 0.f};
    bf16x8 At[4][2], B0[2][2], B1[2][2];
    const char* cA = (const char*)g.A + (size_t)cur.pm * tstep; const char* cB = (const char*)g.Bt + (size_t)cur.pn * tstep;
    S.a_ready(cur);
    if constexpr (SP2) {
        PG8_STAGE(PG8_SB(0, 0), cB, voffB); PG8_STAGE(PG8_SB(0, 1), cB + hstep, voffB); PG8_STAGE(PG8_SA(0, 0), cA, voffA); PG8_STAGE(PG8_SA(0, 1), cA + hstep, voffA);
        if (wr == 1) PG8_BAR;
        PG8_WAIT_V(2); PG8_BAR;
        PG8_STAGE(PG8_SB(1, 0), cB + kstep, voffB); PG8_STAGE(PG8_SA(1, 0), cA + kstep, voffA); PG8_STAGE(PG8_SB(1, 1), cB + hstep + kstep, voffB);
        PG8_WAIT_V(6); PG8_BAR;
    } else {
        PG8_STAGE(PG8_SB(0, 0), cB, voffB); PG8_STAGE(PG8_SA(0, 0), cA, voffA); PG8_STAGE(PG8_SB(0, 1), cB + hstep, voffB); PG8_STAGE(PG8_SA(0, 1), cA + hstep, voffA);
        if (wr == 1) PG8_BAR;
        PG8_WAIT_V(4); PG8_BAR;
        PG8_STAGE(PG8_SB(1, 0), cB + kstep, voffB); PG8_STAGE(PG8_SA(1, 0), cA + kstep, voffA); PG8_STAGE(PG8_SB(1, 1), cB + hstep + kstep, voffB);
        PG8_WAIT_V(6); PG8_BAR;
    }
    for (;;) {
        const bool has_next = S.next(ui + 1, nxt);
        const char* nA = has_next ? (const char*)g.A + (size_t)nxt.pm * tstep : cA; const char* nB = has_next ? (const char*)g.Bt + (size_t)nxt.pn * tstep : cB;
        for (int t = 0; t < nt; t += 2) {
            const bool last = (t == nt - 2);
            const char* a1 = cA + (size_t)(t + 1) * kstep;
            const char* a2 = last ? nA : cA + (size_t)(t + 2) * kstep; const char* b2 = last ? nB : cB + (size_t)(t + 2) * kstep;
            const char* a3 = a2 + kstep; const char* b3 = b2 + kstep;
            if (last && has_next) S.a_ready(nxt);
            if constexpr (SP2) {
            PG8_LDB(B0, 0, 0); PG8_LDB(B1, 0, 1); PG8_SCHED; PG8_LDA(At, 0, 0); PG8_STAGE(PG8_SA(1, 1), a1 + hstep, voffA);
            PG8_WAIT_V(8); PG8_WAIT_L(0); PG8_BAR; PG8_MMA(0, 0, At, B0); PG8_MMA(0, 1, At, B1); PG8_BAR; PG8_SCHED;
            PG8_LDA(At, 0, 1); PG8_STAGE(PG8_SB(0, 0), b2, voffB); PG8_STAGE(PG8_SB(0, 1), b2 + hstep, voffB); PG8_STAGE(PG8_SA(0, 0), a2, voffA);
            PG8_WAIT_V(8); PG8_WAIT_L(0); PG8_BAR; PG8_MMA(1, 0, At, B0); PG8_MMA(1, 1, At, B1); PG8_BAR; PG8_SCHED;
            PG8_LDB(B0, 1, 0); PG8_LDB(B1, 1, 1); PG8_SCHED; PG8_LDA(At, 1, 0); PG8_STAGE(PG8_SA(0, 1), a2 + hstep, voffA);
            PG8_WAIT_V(8); PG8_WAIT_L(0); PG8_BAR; PG8_MMA(0, 0, At, B0); PG8_MMA(0, 1, At, B1); PG8_BAR; PG8_SCHED;
            PG8_LDA(At, 1, 1); PG8_STAGE(PG8_SB(1, 0), b3, voffB); PG8_STAGE(PG8_SB(1, 1), b3 + hstep, voffB); PG8_STAGE(PG8_SA(1, 0), a3, voffA);
            PG8_WAIT_V(8); PG8_WAIT_L(0); PG8_BAR; PG8_MMA(1, 0, At, B0); PG8_MMA(1, 1, At, B1); PG8_BAR; PG8_SCHED;
            } else {
            PG8_LDB(B0, 0, 0); PG8_SCHED; PG8_LDA(At, 0, 0); PG8_STAGE(PG8_SA(1, 1), a1 + hstep, voffA);
            PG8_WAIT_L(8); PG8_BAR; PG8_WAIT_L(0); PG8_MMA(0, 0, At, B0); PG8_BAR; PG8_SCHED;
            PG8_LDB(B1, 0, 1); PG8_STAGE(PG8_SB(0, 0), b2, voffB);
            PG8_BAR; PG8_WAIT_L(0); PG8_MMA(0, 1, At, B1); PG8_BAR;
            PG8_LDA(At, 0, 1); PG8_STAGE(PG8_SA(0, 0), a2, voffA);
            PG8_BAR; PG8_WAIT_L(0); PG8_MMA(1, 0, At, B0); PG8_BAR; PG8_SCHED;
            PG8_STAGE(PG8_SB(0, 1), b2 + hstep, voffB);
            PG8_WAIT_V(6); PG8_BAR; PG8_MMA(1, 1, At, B1); PG8_BAR;
            PG8_LDB(B0, 1, 0); PG8_SCHED; PG8_LDA(At, 1, 0); PG8_STAGE(PG8_SA(0, 1), a2 + hstep, voffA);
            PG8_WAIT_L(8); PG8_BAR; PG8_WAIT_L(0); PG8_MMA(0, 0, At, B0); PG8_BAR; PG8_SCHED;
            PG8_LDB(B1, 1, 1); PG8_STAGE(PG8_SB(1, 0), b3, voffB);
            PG8_BAR; PG8_WAIT_L(0); PG8_MMA(0, 1, At, B1); PG8_BAR;
            PG8_LDA(At, 1, 1); PG8_STAGE(PG8_SA(1, 0), a3, voffA);
            PG8_BAR; PG8_WAIT_L(0); PG8_MMA(1, 0, At, B0); PG8_BAR; PG8_SCHED;
            PG8_STAGE(PG8_SB(1, 1), b3 + hstep, voffB);
            PG8_WAIT_V(6); PG8_BAR; PG8_MMA(1, 1, At, B1); PG8_BAR;
            }
        }
        if constexpr (ALIGN_EPI) { if (wr == 0) PG8_BAR; }
        if constexpr (!Epi::AFTER_DRAIN) { E(acc, cur, wr, wc, fr, fq); S.done(cur); }
        if (!has_next) break;
#pragma unroll
        for (int a = 0; a < 2; ++a)
#pragma unroll
            for (int b = 0; b < 2; ++b)
#pragma unroll
                for (int m = 0; m < 4; ++m)
#pragma unroll
                    for (int n = 0; n < 2; ++n) acc[a][b][m][n] = (f32x4){0.f, 0.f, 0.f, 0.f};
        cur = nxt; cA = nA; cB = nB; ++ui;
        if constexpr (ALIGN_EPI) { if (wr == 1) PG8_BAR; }
    }
    PG8_WAIT_V(0);
    if constexpr (!ALIGN_EPI) { if (wr == 0) PG8_BAR; }
    PG8_BAR;
    if constexpr (Epi::AFTER_DRAIN) { E.fused(acc, cur, wr, wc, fr, fq, lds, wid, lane); S.done(cur); }
#undef PG8_SA
#undef PG8_SB
#undef PG8_STAGE
#undef PG8_LDA
#undef PG8_LDB
#undef PG8_MMA
#undef PG8_WAIT_V
#undef PG8_WAIT_L
#undef PG8_BAR
#undef PG8_SCHED
}
}
#define GAS __attribute__((address_space(1)))
#define LAS __attribute__((address_space(3)))
typedef unsigned short bf16;
typedef unsigned v4u __attribute__((ext_vector_type(4)));
typedef float f32x4 __attribute__((ext_vector_type(4)));
typedef short bf16x8 __attribute__((ext_vector_type(8)));
typedef GAS unsigned gu32;
typedef GAS unsigned long long gu64;
#define RLX_AGENT __ATOMIC_RELAXED, __HIP_MEMORY_SCOPE_AGENT
#define LDS_WAIT() asm volatile("s_waitcnt lgkmcnt(0)" ::: "memory")
#define VM_WAIT() asm volatile("s_waitcnt vmcnt(0)" ::: "memory")
__device__ __forceinline__ unsigned long long rt() { return __builtin_amdgcn_s_memrealtime(); }
__device__ __forceinline__ unsigned f2bf(float f) { unsigned u = __builtin_bit_cast(unsigned, f); return (u + 0x7fffu + ((u >> 16) & 1u)) >> 16; }
__device__ __forceinline__ unsigned pk2(float lo, float hi) { return f2bf(lo) | (f2bf(hi) << 16); }
#define XB_TMO      128
#define XB_XCNT(j)  (256  + 64 * (j))
#define XB_XSUB(j)  (1280 + 64 * (j))
#define XB_XGEN(j)  (2304 + 64 * (j))
#define XB_TOP      3328
#define XB_TOPGEN   3392
#define XCD_BAR_WORDS 3456
#define XB_SPIN_CAP (1u << 18)

__device__ __forceinline__ unsigned xb_ld(unsigned* p)              { return __hip_atomic_load(p, __ATOMIC_RELAXED, __HIP_MEMORY_SCOPE_AGENT); }
__device__ __forceinline__ unsigned xb_add(unsigned* p, unsigned v) { return __hip_atomic_fetch_add(p, v, __ATOMIC_RELAXED, __HIP_MEMORY_SCOPE_AGENT); }
__device__ __forceinline__ unsigned xb_xcc_id() { return (unsigned)__builtin_amdgcn_s_getreg((3 << 11) | 20) & 0xFu; }
#define XB_SPIN(cond, bar) do { unsigned _sp = 0; while (cond) { __builtin_amdgcn_s_sleep(1); \
    if ((++_sp & 255u) == 0u) { if (xb_ld(&(bar)[XB_TMO])) break; if (_sp > XB_SPIN_CAP) { atomicAdd(&(bar)[XB_TMO], 1u); break; } } } } while (0)

struct XcdBarrier {
    unsigned* bar; unsigned x;
    volatile LAS unsigned* st;
};

__device__ __forceinline__ XcdBarrier xcd_barrier_post(unsigned* bar, volatile LAS unsigned* st) {
    XcdBarrier b; b.bar = bar; b.x = xb_xcc_id(); b.st = st;
    if (threadIdx.x == 0) (void)xb_add(&bar[XB_XCNT(b.x)], 1u);
    return b;
}
__device__ __forceinline__ void xcd_barrier_complete(unsigned* bar, unsigned x, unsigned& nloc, unsigned& nx) {
    const unsigned G = gridDim.x * gridDim.y * gridDim.z;
    unsigned sum, cnt, mine, sp = 0u;
    for (;;) {
        sum = 0u; cnt = 0u; mine = 0u;
#pragma unroll
        for (unsigned j = 0; j < 16; ++j) { const unsigned c = xb_ld(&bar[XB_XCNT(j)]); sum += c; cnt += (c > 0u) ? 1u : 0u; mine = (j == x) ? c : mine; }
        if (sum == G) break;
        __builtin_amdgcn_s_sleep(1);
        if ((++sp & 255u) == 0u) { if (xb_ld(&bar[XB_TMO])) break; if (sp > XB_SPIN_CAP) { atomicAdd(&bar[XB_TMO], 1u); break; } }
    }
    nloc = mine > 0u ? mine : 1u; nx = cnt > 0u ? cnt : 1u;
}

__device__ __forceinline__ void xcd_barrier(const XcdBarrier& b) {
    asm volatile("s_waitcnt vmcnt(0)" ::: "memory");
    __syncthreads();
    if (threadIdx.x == 0) {
        unsigned* bar = b.bar;
        __builtin_amdgcn_s_waitcnt(0);
        unsigned nloc = b.st[0], nx = b.st[1];
        if (nloc == 0u) { xcd_barrier_complete(bar, b.x, nloc, nx); b.st[0] = nloc; b.st[1] = nx; }
        const unsigned old = xb_add(&bar[XB_XSUB(b.x)], 1u);
        const unsigned gen = old / nloc;
        if (old + 1u == (gen + 1u) * nloc) {
            __builtin_amdgcn_fence(__ATOMIC_RELEASE, "agent");
            asm volatile("s_waitcnt vmcnt(0)" ::: "memory");
            const unsigned og = xb_add(&bar[XB_TOP], 1u);
            const unsigned tg = og / nx;
            if (og + 1u == (tg + 1u) * nx) xb_add(&bar[XB_TOPGEN], 1u);
            else XB_SPIN(xb_ld(&bar[XB_TOPGEN]) == tg, bar);
            __builtin_amdgcn_fence(__ATOMIC_ACQUIRE, "agent");
            xb_add(&bar[XB_XGEN(b.x)], 1u);
            asm volatile("s_waitcnt vmcnt(0)" ::: "memory");
        } else {
            XB_SPIN(xb_ld(&bar[XB_XGEN(b.x)]) == gen, bar);
            __builtin_amdgcn_fence(__ATOMIC_ACQUIRE, "agent");
            asm volatile("s_waitcnt vmcnt(0)" ::: "memory");
        }
    }
    __syncthreads();
}

constexpr int NWAVES = 8;
constexpr int DM = 2048, RP = 8192, RS = 512, RT = RP + RS;
constexpr int PROJW = 9872, NPT = 39, PROJP = NPT * 256;
constexpr int LS = 2080, LSP = 2176;
constexpr int KROWS = RP + 16 * LSP;
constexpr float EPS = 1e-6f;
constexpr float LOG2E = 1.4426950408889634f;
constexpr float SC_DSA = 0.08838834764831845f * LOG2E;
constexpr float SC_MLA = 0.07216878364870323f * LOG2E;
constexpr float NEG_INF = -__builtin_inff();

enum { I_XP = 0, I_XS, I_CAK, I_CAV, I_CIK, I_CCKV, I_CKR, I_NG, I_WIN, I_WUQ, I_QNG, I_KVNG, I_WUK, I_WUV, I_WOA, I_WOB, I_WOUT, I_FG };

constexpr size_t O_Y = 0, O_PK = 17825792, O_PV = 19922944, O_PIK = 22020096, O_PCKV = 22544384, O_PKR = 26738688,
                 O_SK = 27262976, O_SV = 27394048, O_SIK = 27525120, O_SCKV = 27557888, O_SKR = 27820032, O_END = 27852800;

constexpr size_t MiB = 1u << 20;
constexpr size_t WS_CTL = 0, CTL_ZERO_BYTES = 65536;
constexpr size_t WS_ROPE = 1 * MiB;
constexpr size_t WS_WIN_T = 2 * MiB;
constexpr size_t WS_BIAS_P = WS_WIN_T;
constexpr size_t WS_WUQ_T = 41 * MiB;
constexpr size_t WS_WUKV_T = WS_WUQ_T + 1536 * 512 * 2;
constexpr size_t WS_WUK_B = WS_WUKV_T + 2 * MiB;
constexpr size_t WS_WUV_T = WS_WUK_B + 1 * MiB;
constexpr size_t WS_WOA_T = WS_WUV_T + 1 * MiB;
constexpr size_t WS_WOB_T = WS_WOA_T + 4 * MiB;
constexpr size_t WS_WOUT_T = WS_WOB_T + 4 * MiB;
constexpr size_t WS_AQ = WS_WOUT_T + 8 * MiB;
constexpr size_t WS_IQ = WS_AQ + 17 * MiB;
constexpr size_t WS_AGATE = WS_IQ + 17 * MiB;
constexpr size_t WS_BGATE = WS_AGATE + 17 * MiB;
constexpr size_t WS_G = WS_BGATE + 17 * MiB;
constexpr size_t WS_CQ = WS_G + 68 * MiB;
constexpr size_t WS_CKV = WS_CQ + (size_t)RT * 512 * 2;
constexpr size_t WS_AKC = WS_CKV + (size_t)RT * 512 * 2;
constexpr size_t WS_AVC = WS_AKC + (size_t)KROWS * 256 * 2;
constexpr size_t WS_IKC = WS_AVC + (size_t)KROWS * 256 * 2;
constexpr size_t WS_KRP = WS_IKC + (size_t)KROWS * 64 * 2;
constexpr size_t WS_KCAT = WS_KRP + (size_t)RT * 64 * 2;
constexpr size_t WS_IW = WS_KCAT + (size_t)16 * LSP * 576 * 2;
constexpr size_t WS_SSQQ = WS_IW + (size_t)RT * 16 * 4;
constexpr size_t WS_SSQKV = WS_SSQQ + (size_t)RT * 8 * 4;
constexpr size_t WS_SSQH = WS_SSQKV + (size_t)RT * 8 * 4;
constexpr size_t WS_BIAS_S = WS_SSQH + (size_t)RT * 32 * 4;
constexpr size_t WS_END = WS_BIAS_S + (size_t)RS * LSP * 4;
static_assert(WS_END <= 344000000ull, "ws budget");
static_assert(WS_WIN_T + (size_t)PROJP * DM * 2 <= WS_WUQ_T, "Win_t");
constexpr size_t TRI_B = 4096ull * 559;
static_assert(4 * TRI_B * 4 <= 39 * MiB, "bias_p fits the Win_t region");
constexpr size_t DO_XN = 0, DO_QN = 0, DO_QR = 17 * MiB, DO_KN = DO_QR + (size_t)RT * 512 * 2, DO_V = DO_KN + 16 * MiB;
static_assert(DO_V + 16 * MiB <= (size_t)RT * DM * 4, "y-region overlay");

constexpr int CW_TMO = 0, CW_Q3 = 64, CW_Q4 = 128, CW_Q4A = 192, CW_BAR = 4096;
static_assert((CW_BAR + XCD_BAR_WORDS) * 4 <= (int)CTL_ZERO_BYTES, "ctl");

constexpr int RING_OFF = 0, RING_BYTES = 131072;
constexpr int LDS_BYTES = 163840;
constexpr int LDSCTL_OFF = LDS_BYTES - 512, MISC_OFF = LDSCTL_OFF + 320;

constexpr int RT_COSA = 0, RT_COSI = 16, RT_COSR = 24, RT_SINA = 56, RT_SINI = 72, RT_SINR = 80, RT_W = 112;
__constant__ double INVF[56] = {
  1.0, 0.44036660267178046, 0.19392274474868576, 0.08539710028576561, 0.03760603093086393, 0.016560440080994446, 0.007292664737217109, 0.003211445994752591,
  0.001414213562373095, 0.000622772421914596, 0.0002742481756762073, 0.00012076973741146504, 5.318295896944988e-05, 2.341999896140934e-05, 1.031338537721246e-05, 4.5416704806078695e-06,
  1.0, 0.19392274474868576, 0.03760603093086393, 0.007292664737217109, 0.001414213562373095, 0.0002742481756762073, 5.318295896944988e-05, 1.031338537721246e-05,
  1.0, 0.6636012376960885, 0.44036660267178046, 0.2922278225730151, 0.19392274474868576, 0.12868737343265052, 0.08539710028576561, 0.05666962144529105,
  0.03760603093086393, 0.024955408670558694, 0.016560440080994446, 0.010989528534539826, 0.007292664737217109, 0.004839421345719893, 0.003211445994752591, 0.0021311195369119653,
  0.001414213562373095, 0.0009384738703573802, 0.000622772421914596, 0.0004132725499855165, 0.0002742481756762073, 0.00018199142881462546, 0.00012076973741146504, 8.01429472224798e-05,
  5.318295896944988e-05, 3.529227739646723e-05, 2.341999896140934e-05, 1.5541540297632344e-05, 1.031338537721246e-05, 6.8439753011549275e-06, 4.5416704806078695e-06, 3.013858152139171e-06 };

typedef float f32x16 __attribute__((ext_vector_type(16)));
typedef short s16x4 __attribute__((ext_vector_type(4)));
typedef unsigned u32x2 __attribute__((ext_vector_type(2)));

struct Frame {
    LAS unsigned char* lds;
    volatile LAS unsigned* MISC;
    gu32* ctl;
    int tid, lane, wave, vcu, G;
    const float* in[18];
    float* out;
    unsigned char* ws;
};
__device__ __forceinline__ float wave_sum(float v) {
#pragma unroll
    for (int o = 1; o < 64; o <<= 1) v += __shfl_xor(v, o);
    return v;
}
typedef float f32x2_t __attribute__((ext_vector_type(2))); typedef __bf16 bf16x2_t __attribute__((ext_vector_type(2)));
__device__ __forceinline__ unsigned cvtpk(float lo, float hi) { const f32x2_t v = {lo, hi}; const bf16x2_t b = __builtin_convertvector(v, bf16x2_t); return __builtin_bit_cast(unsigned, b); }
__device__ __forceinline__ float bf2f(unsigned short b) { return __builtin_bit_cast(float, (unsigned)b << 16); }
__device__ __forceinline__ int row_pos(int row) { return row < RP ? (row & 2047) : 2048 + ((row - RP) & 31); }
__device__ __forceinline__ int krow_of(int row) { return row < RP ? row : RP + ((row - RP) >> 5) * LSP + 2048 + ((row - RP) & 31); }
__device__ __forceinline__ float silu_f(float x) { return x / (1.f + __expf(-x)); }
__device__ __forceinline__ float sigm_f(float x) { return 1.f / (1.f + __expf(-x)); }

__device__ __forceinline__ int map_win(int j) {
    if (j < 3584) return j;
    if (j < 3840) { const int c = j - 3584;
        if (c < 64) return 3584 + c;
        if (c < 80) return 3648 + (c - 64);
        if (c < 128) return -1;
        if (c < 192) { const int cp = c - 128, grp = cp >> 5, w = cp & 31, n = w >> 4, i = (w & 15) + 16 * grp; return 4688 + i + 32 * n; }
        return -1; }
    if (j < 4352) return 3664 + (j - 3840);
    if (j < 4864) return 4176 + (j - 4352);
    if (j < 5888) return 4752 + (j - 4864);
    return 5776 + (j - 5888);
}
__device__ __forceinline__ int map_wuq(int j) {
    if (j < 1024) return (j >> 7) * 192 + (j & 127);
    const int jp = j - 1024, h = jp >> 6, cp = jp & 63, grp = cp >> 5, w = cp & 31, n = w >> 4, i = (w & 15) + 16 * grp;
    return h * 192 + 128 + i + 32 * n;
}
template <int MODE>
__device__ __forceinline__ void p0_transpose_item(const float* W, int K, int Nsrc, bf16* WT, int row_off, int nblk, const float* kscale, LAS float* scr, int item, int lane) {
    const int kb = item / nblk, nb = item % nblk, k0 = 64 * kb, n0 = 32 * nb;
    const int jn = n0 + (lane & 31);
    const int src = MODE == 0 ? map_win(jn) : (MODE == 1 ? map_wuq(jn) : jn);
#pragma unroll 8
    for (int i = 0; i < 32; ++i) { const int kk = 2 * i + (lane >> 5);
        float v = src >= 0 ? W[(size_t)(k0 + kk) * Nsrc + src] : 0.f;
        if (kscale) v *= kscale[k0 + kk];
        scr[kk * 33 + (lane & 31)] = v; }
    LDS_WAIT(); asm volatile("" ::: "memory");
    const int c = lane & 7;
#pragma unroll
    for (int j = 0; j < 4; ++j) { const int n = (lane >> 3) + 8 * j; const LAS float* s = scr + (8 * c) * 33 + n;
        v4u o; o.x = pk2(s[0 * 33], s[1 * 33]); o.y = pk2(s[2 * 33], s[3 * 33]); o.z = pk2(s[4 * 33], s[5 * 33]); o.w = pk2(s[6 * 33], s[7 * 33]);
        *(GAS v4u*)(WT + (size_t)(row_off + n0 + n) * K + k0 + 8 * c) = o; }
    LDS_WAIT(); asm volatile("" ::: "memory");
}
__device__ __forceinline__ v4u cvt8(const float* p) {
    const f32x4 a = *(const GAS f32x4*)p, b = *(const GAS f32x4*)(p + 4);
    v4u o; o.x = cvtpk(a.x, a.y); o.y = cvtpk(a.z, a.w); o.z = cvtpk(b.x, b.y); o.w = cvtpk(b.z, b.w); return o;
}
__device__ __forceinline__ void p0_prologue(Frame& F) {
    LAS float* scr = (LAS float*)(F.lds + RING_OFF + F.wave * 16384);
    const int gw = F.vcu * NWAVES + F.wave, NGW = F.G * NWAVES;
    bf16* win_t = (bf16*)(F.ws + WS_WIN_T); bf16* wuq_t = (bf16*)(F.ws + WS_WUQ_T); bf16* wukv_t = (bf16*)(F.ws + WS_WUKV_T);
    bf16* wuv_t = (bf16*)(F.ws + WS_WUV_T); bf16* woa_t = (bf16*)(F.ws + WS_WOA_T); bf16* wob_t = (bf16*)(F.ws + WS_WOB_T); bf16* wout_t = (bf16*)(F.ws + WS_WOUT_T);
    constexpr int I_IN = 32 * (PROJP / 32), I_UQ = 8 * 48, I_UK = 8 * 32, I_UV = 8 * 32, I_UVT = 8 * 32, I_OA = 16 * 64, I_OB = 16 * 64, I_OUT = 32 * 64;
    constexpr int NITEMS = I_IN + I_UQ + I_UK + I_UV + I_UVT + I_OA + I_OB + I_OUT;
    for (int it = gw; it < NITEMS; it += NGW) {
        int r = it;
        if (r < I_IN) { p0_transpose_item<0>(F.in[I_WIN], DM, PROJW, win_t, 0, PROJP / 32, nullptr, scr, r, F.lane); continue; } r -= I_IN;
        if (r < I_UQ) { p0_transpose_item<1>(F.in[I_WUQ], 512, 1536, wuq_t, 0, 48, F.in[I_QNG], scr, r, F.lane); continue; } r -= I_UQ;
        if (r < I_UK) { p0_transpose_item<2>(F.in[I_WUK], 512, 1024, wukv_t, 0, 32, F.in[I_KVNG], scr, r, F.lane); continue; } r -= I_UK;
        if (r < I_UV) { p0_transpose_item<2>(F.in[I_WUV], 512, 1024, wukv_t, 1024, 32, F.in[I_KVNG], scr, r, F.lane); continue; } r -= I_UV;
        if (r < I_UVT) { p0_transpose_item<2>(F.in[I_WUV], 512, 1024, wuv_t, 0, 32, nullptr, scr, r, F.lane); continue; } r -= I_UVT;
        if (r < I_OA) { p0_transpose_item<2>(F.in[I_WOA], 1024, 2048, woa_t, 0, 64, nullptr, scr, r, F.lane); continue; } r -= I_OA;
        if (r < I_OB) { p0_transpose_item<2>(F.in[I_WOB], 1024, 2048, wob_t, 0, 64, nullptr, scr, r, F.lane); continue; } r -= I_OB;
        p0_transpose_item<2>(F.in[I_WOUT], 2048, 2048, wout_t, 0, 64, nullptr, scr, r, F.lane);
    }
    {   bf16* XN = (bf16*)((unsigned char*)F.out + DO_XN); const float* g = F.in[I_NG];
        for (int m = gw; m < RT; m += NGW) {
            const float* xrow = m < RP ? F.in[I_XP] + (size_t)m * DM : F.in[I_XS] + (size_t)(m - RP) * DM;
            const GAS f32x4* xr = (const GAS f32x4*)xrow + F.lane; const GAS f32x4* gr = (const GAS f32x4*)g + F.lane;
            f32x4 v[8]; float s = 0.f;
#pragma unroll
            for (int j = 0; j < 8; ++j) { v[j] = xr[64 * j]; s += (v[j].x * v[j].x + v[j].y * v[j].y) + (v[j].z * v[j].z + v[j].w * v[j].w); }
            const float rs = 1.0f / sqrtf(wave_sum(s) * (1.f / DM) + EPS);
            GAS u32x2* o8 = (GAS u32x2*)(XN + (size_t)m * DM) + F.lane;
#pragma unroll
            for (int j = 0; j < 8; ++j) { const f32x4 gg = gr[64 * j]; u32x2 w; w.x = cvtpk(v[j].x * rs * gg.x, v[j].y * rs * gg.y); w.y = cvtpk(v[j].z * rs * gg.z, v[j].w * rs * gg.w); o8[64 * j] = w; }
        }
    }
    {   const long gt = (long)F.vcu * (NWAVES * 64) + F.tid, NGT = (long)F.G * NWAVES * 64;
        bf16* akc = (bf16*)(F.ws + WS_AKC); bf16* avc = (bf16*)(F.ws + WS_AVC); bf16* ikc = (bf16*)(F.ws + WS_IKC); bf16* kcat = (bf16*)(F.ws + WS_KCAT); bf16* wuk_b = (bf16*)(F.ws + WS_WUK_B);
        for (long i = gt; i < 512 * 1024 / 8; i += NGT) *(GAS v4u*)(wuk_b + i * 8) = cvt8(F.in[I_WUK] + i * 8);
        for (long i = gt; i < 16L * 2048 * 32; i += NGT) { const long b = i >> 16, rem = i & 65535; const long s = rem >> 5, c8 = rem & 31;
            const size_t d = ((size_t)(RP + b * LSP + s) * 256 + c8 * 8);
            *(GAS v4u*)(akc + d) = cvt8(F.in[I_CAK] + i * 8); *(GAS v4u*)(avc + d) = cvt8(F.in[I_CAV] + i * 8); }
        for (long i = gt; i < 16L * 2048 * 8; i += NGT) { const long b = i >> 14, rem = i & 16383; const long s = rem >> 3, c8 = rem & 7;
            *(GAS v4u*)(ikc + ((size_t)(RP + b * LSP + s) * 64 + c8 * 8)) = cvt8(F.in[I_CIK] + i * 8); }
        for (long i = gt; i < 16L * 2048 * 64; i += NGT) { const long b = i >> 17, rem = i & 131071; const long s = rem >> 6, c8 = rem & 63;
            *(GAS v4u*)(kcat + ((size_t)(b * LSP + s) * 576 + c8 * 8)) = cvt8(F.in[I_CCKV] + i * 8); }
        for (long i = gt; i < 16L * 2048 * 8; i += NGT) { const long b = i >> 14, rem = i & 16383; const long s = rem >> 3, c8 = rem & 7;
            *(GAS v4u*)(kcat + ((size_t)(b * LSP + s) * 576 + 512 + c8 * 8)) = cvt8(F.in[I_CKR] + i * 8); }
        const v4u z = {0u, 0u, 0u, 0u};
        for (long i = gt; i < 16L * (LSP - LS) * 32; i += NGT) { const long b = i / ((LSP - LS) * 32), rem = i % ((LSP - LS) * 32); const long s = LS + rem / 32, c8 = rem % 32;
            const size_t d = ((size_t)(RP + b * LSP + s) * 256 + c8 * 8); *(GAS v4u*)(akc + d) = z; *(GAS v4u*)(avc + d) = z; }
        for (long i = gt; i < 16L * (LSP - LS) * 72; i += NGT) { const long b = i / ((LSP - LS) * 72), rem = i % ((LSP - LS) * 72); const long s = LS + rem / 72, c8 = rem % 72;
            *(GAS v4u*)(kcat + ((size_t)(b * LSP + s) * 576 + c8 * 8)) = z; }
        float* tab = (float*)(F.ws + WS_ROPE);
        for (long i = gt; i < 2080L * 56; i += NGT) { const int pos = (int)(i / 56), f = (int)(i % 56);
            const double a = (double)pos * INVF[f]; const double n = __builtin_rint(a * 0.15915494309189535);
            double r = __builtin_fma(-n, 6.283185307179586, a); r = __builtin_fma(-n, 2.4492935982947064e-16, r);
            const float rf = (float)r; tab[(size_t)pos * RT_W + f] = cosf(rf); tab[(size_t)pos * RT_W + 56 + f] = sinf(rf); }
    }
}

using pg8::Unit;
#define EPI_ROWS(ai, m) (u.pm * 256 + (ai) * 128 + wr * 64 + (m) * 16 + fr)
__device__ __forceinline__ void st_bf4(bf16* p, const f32x4 v) { u32x2 w; w.x = cvtpk(v.x, v.y); w.y = cvtpk(v.z, v.w); *(GAS u32x2*)p = w; }
__device__ __forceinline__ void st_f4(float* p, const f32x4 v) { *(GAS f32x4*)p = v; }

struct EpiInProj {
    static constexpr bool PERM = false, AFTER_DRAIN = false;
    float* out; unsigned char* ws;
    __device__ __forceinline__ void operator()(f32x4 (&acc)[2][2][4][2], const Unit& u, int wr, int wc, int fr, int fq) const {
        const int pn = u.pn; const bool samp = u.pm >= 32;
        const float* tab = (const float*)(ws + WS_ROPE);
        const int cl = wc * 32 + 4 * fq;
        if (pn < 5) {
            bf16* AQ = (bf16*)(ws + WS_AQ); bf16* AKC = (bf16*)(ws + WS_AKC);
            float* OK = samp ? out + O_SK : out + O_PK;
#pragma unroll
            for (int ai = 0; ai < 2; ++ai)
#pragma unroll
                for (int m = 0; m < 4; ++m) { int row = EPI_ROWS(ai, m); asm volatile("" : "+v"(row) :: "memory");
                    if (wc == 0) { const float* tp = tab + (size_t)row_pos(row) * RT_W + 4 * fq; const f32x4 cs = *(const GAS f32x4*)(tp + RT_COSA), sn = *(const GAS f32x4*)(tp + RT_SINA);
#pragma unroll
                        for (int bj = 0; bj < 2; ++bj) { const f32x4 x1 = acc[ai][bj][m][0], x2 = acc[ai][bj][m][1]; acc[ai][bj][m][0] = x1 * cs - x2 * sn; acc[ai][bj][m][1] = x2 * cs + x1 * sn; } }
#pragma unroll
                    for (int bj = 0; bj < 2; ++bj)
#pragma unroll
                        for (int n = 0; n < 2; ++n) { const int c = bj * 128 + n * 16 + cl;
                            if (pn < 4) st_bf4(AQ + (size_t)row * 1024 + pn * 256 + c, acc[ai][bj][m][n]);
                            else { st_bf4(AKC + (size_t)krow_of(row) * 256 + c, acc[ai][bj][m][n]); st_f4(OK + (size_t)(samp ? row - RP : row) * 256 + c, acc[ai][bj][m][n]); } } }
        } else if (pn == 5) {
            bf16* AVC = (bf16*)(ws + WS_AVC); float* OV = samp ? out + O_SV : out + O_PV;
#pragma unroll
            for (int ai = 0; ai < 2; ++ai)
#pragma unroll
                for (int m = 0; m < 4; ++m) { int row = EPI_ROWS(ai, m); asm volatile("" : "+v"(row) :: "memory");
#pragma unroll
                    for (int bj = 0; bj < 2; ++bj)
#pragma unroll
                        for (int n = 0; n < 2; ++n) { const int c = bj * 128 + n * 16 + cl;
                            st_bf4(AVC + (size_t)krow_of(row) * 256 + c, acc[ai][bj][m][n]); st_f4(OV + (size_t)(samp ? row - RP : row) * 256 + c, acc[ai][bj][m][n]); } }
        } else if (pn < 10 || (pn >= 19 && pn < 23)) {
            bf16* Gt = pn < 10 ? (bf16*)(ws + WS_AGATE) + (pn - 6) * 256 : (bf16*)(ws + WS_BGATE) + (pn - 19) * 256;
#pragma unroll
            for (int ai = 0; ai < 2; ++ai)
#pragma unroll
                for (int m = 0; m < 4; ++m) { int row = EPI_ROWS(ai, m); asm volatile("" : "+v"(row) :: "memory");
#pragma unroll
                    for (int bj = 0; bj < 2; ++bj)
#pragma unroll
                        for (int n = 0; n < 2; ++n) { f32x4 v = acc[ai][bj][m][n]; v.x = silu_f(v.x); v.y = silu_f(v.y); v.z = silu_f(v.z); v.w = silu_f(v.w);
                            st_bf4(Gt + (size_t)row * 1024 + bj * 128 + n * 16 + cl, v); } }
        } else if (pn < 14) {
            bf16* IQ = (bf16*)(ws + WS_IQ) + (pn - 10) * 256;
#pragma unroll
            for (int ai = 0; ai < 2; ++ai)
#pragma unroll
                for (int m = 0; m < 4; ++m) { int row = EPI_ROWS(ai, m); asm volatile("" : "+v"(row) :: "memory");
                    if ((wc & 1) == 0) { const float* tp = tab + (size_t)row_pos(row) * RT_W + 4 * (fq & 1); const f32x4 cs = *(const GAS f32x4*)(tp + RT_COSI), sn = *(const GAS f32x4*)(tp + RT_SINI);
#pragma unroll
                        for (int bj = 0; bj < 2; ++bj) { const f32x4 v = acc[ai][bj][m][0]; f32x4 o;
                            o.x = __shfl_xor(v.x, 32); o.y = __shfl_xor(v.y, 32); o.z = __shfl_xor(v.z, 32); o.w = __shfl_xor(v.w, 32);
                            acc[ai][bj][m][0] = fq < 2 ? v * cs - o * sn : v * cs + o * sn; } }
#pragma unroll
                    for (int bj = 0; bj < 2; ++bj)
#pragma unroll
                        for (int n = 0; n < 2; ++n) st_bf4(IQ + (size_t)row * 1024 + bj * 128 + n * 16 + cl, acc[ai][bj][m][n]); }
        } else if (pn == 14) {
            bf16* IKC = (bf16*)(ws + WS_IKC); bf16* KRP = (bf16*)(ws + WS_KRP); bf16* KCAT = (bf16*)(ws + WS_KCAT); float* IW = (float*)(ws + WS_IW);
            float* OIK = samp ? out + O_SIK : out + O_PIK; float* OKR = samp ? out + O_SKR : out + O_PKR;
#pragma unroll
            for (int ai = 0; ai < 2; ++ai)
#pragma unroll
                for (int m = 0; m < 4; ++m) { int row = EPI_ROWS(ai, m); asm volatile("" : "+v"(row) :: "memory"); const int orow = samp ? row - RP : row; const int pos = row_pos(row);
                    if (wc < 2) {
                        if (wc == 0) { const float* tp = tab + (size_t)pos * RT_W + 4 * (fq & 1); const f32x4 cs = *(const GAS f32x4*)(tp + RT_COSI), sn = *(const GAS f32x4*)(tp + RT_SINI);
                            const f32x4 v = acc[ai][0][m][0]; f32x4 o; o.x = __shfl_xor(v.x, 32); o.y = __shfl_xor(v.y, 32); o.z = __shfl_xor(v.z, 32); o.w = __shfl_xor(v.w, 32);
                            acc[ai][0][m][0] = fq < 2 ? v * cs - o * sn : v * cs + o * sn; }
#pragma unroll
                        for (int n = 0; n < 2; ++n) { const int c = n * 16 + cl; st_f4(OIK + (size_t)orow * 64 + c, acc[ai][0][m][n]); st_bf4(IKC + (size_t)krow_of(row) * 64 + c, acc[ai][0][m][n]); }
                        { const int i0 = 16 * wc + 4 * fq; const float* tp = tab + (size_t)pos * RT_W + i0; const f32x4 cs = *(const GAS f32x4*)(tp + RT_COSR), sn = *(const GAS f32x4*)(tp + RT_SINR);
                            const f32x4 x1 = acc[ai][1][m][0], x2 = acc[ai][1][m][1]; const f32x4 o1 = x1 * cs - x2 * sn, o2 = x2 * cs + x1 * sn;
                            st_f4(OKR + (size_t)orow * 64 + i0, o1); st_f4(OKR + (size_t)orow * 64 + 32 + i0, o2);
                            if (samp) { bf16* kc = KCAT + (size_t)(krow_of(row) - RP) * 576 + 512; st_bf4(kc + i0, o1); st_bf4(kc + 32 + i0, o2); }
                            else { st_bf4(KRP + (size_t)row * 64 + i0, o1); st_bf4(KRP + (size_t)row * 64 + 32 + i0, o2); } }
                    } else if (wc == 2) {
                        st_f4(IW + (size_t)row * 16 + 4 * fq, acc[ai][0][m][0] * 0.03125f);
                    } }
        } else if (pn < 19) {
            const bool isq = pn < 17; const int t = isq ? pn - 15 : pn - 17;
            bf16* C = (bf16*)(ws + (isq ? WS_CQ : WS_CKV)) + t * 256; float* SS = (float*)(ws + (isq ? WS_SSQQ : WS_SSQKV));
            float* OC = (samp ? out + O_SCKV : out + O_PCKV) + t * 256;
#pragma unroll
            for (int ai = 0; ai < 2; ++ai)
#pragma unroll
                for (int m = 0; m < 4; ++m) { int row = EPI_ROWS(ai, m); asm volatile("" : "+v"(row) :: "memory"); float s = 0.f;
#pragma unroll
                    for (int bj = 0; bj < 2; ++bj)
#pragma unroll
                        for (int n = 0; n < 2; ++n) { const f32x4 v = acc[ai][bj][m][n]; s += (v.x * v.x + v.y * v.y) + (v.z * v.z + v.w * v.w);
                            st_bf4(C + (size_t)row * 512 + bj * 128 + n * 16 + cl, v);
                            if (!isq) st_f4(OC + (size_t)(samp ? row - RP : row) * 512 + bj * 128 + n * 16 + cl, v); }
                    s += __shfl_xor(s, 16); s += __shfl_xor(s, 32);
                    if (fq == 0) SS[(size_t)row * 8 + t * 4 + wc] = s; }
        } else {
            bf16* Gt = (bf16*)(ws + WS_G) + (pn - 23) * 256;
#pragma unroll
            for (int ai = 0; ai < 2; ++ai)
#pragma unroll
                for (int m = 0; m < 4; ++m) { int row = EPI_ROWS(ai, m); asm volatile("" : "+v"(row) :: "memory");
#pragma unroll
                    for (int bj = 0; bj < 2; ++bj)
#pragma unroll
                        for (int n = 0; n < 2; ++n) { f32x4 v = acc[ai][bj][m][n]; v.x = sigm_f(v.x); v.y = sigm_f(v.y); v.z = sigm_f(v.z); v.w = sigm_f(v.w);
                            st_bf4(Gt + (size_t)row * 4096 + bj * 128 + n * 16 + cl, v); } }
        }
    }
};

struct OrderP2 {
    int G, c;
    __device__ __forceinline__ bool next(int i, Unit& u) const {
        const int L = i * G + c;
        if (L < 204) { u.pm = L / 6; u.pn = L % 6; return true; }
        const int L2 = L - 204; if (L2 >= 256) return false;
        u.pm = 34 + (L2 >> 3); u.pn = 6 + (L2 & 7); return true;
    }
    __device__ __forceinline__ void a_ready(const Unit&) const {}
    __device__ __forceinline__ void done(const Unit&) const {}
};
struct EpiP2 {
    static constexpr bool PERM = false, AFTER_DRAIN = false;
    float* out; unsigned char* ws;
    __device__ __forceinline__ void operator()(f32x4 (&acc)[2][2][4][2], const Unit& u0, int wr, int wc, int fr, int fq) const {
        const bool isq = u0.pn < 6; Unit u; u.pm = isq ? u0.pm : u0.pm - 34; u.pn = isq ? u0.pn : u0.pn - 6;
        const float* SS = (const float*)(ws + (isq ? WS_SSQQ : WS_SSQKV)); const float* tab = (const float*)(ws + WS_ROPE);
        bf16* QN = (bf16*)((unsigned char*)out + DO_QN); bf16* QR = (bf16*)((unsigned char*)out + DO_QR); bf16* KN = (bf16*)((unsigned char*)out + DO_KN); bf16* V = (bf16*)((unsigned char*)out + DO_V);
        const int cl = wc * 32 + 4 * fq;
#pragma unroll
        for (int ai = 0; ai < 2; ++ai)
#pragma unroll
            for (int m = 0; m < 4; ++m) { int row = EPI_ROWS(ai, m); asm volatile("" : "+v"(row) :: "memory");
                const f32x4 s0 = *(const GAS f32x4*)(SS + (size_t)row * 8), s1 = *(const GAS f32x4*)(SS + (size_t)row * 8 + 4);
                const float rs = 1.0f / sqrtf(((s0.x + s0.y) + (s0.z + s0.w) + (s1.x + s1.y) + (s1.z + s1.w)) * (1.f / 512.f) + EPS);
                if (isq && u.pn >= 4) {
                    const int i0 = 16 * (wc & 1) + 4 * fq; const float* tp = tab + (size_t)row_pos(row) * RT_W + i0; const f32x4 cs = *(const GAS f32x4*)(tp + RT_COSR), sn = *(const GAS f32x4*)(tp + RT_SINR);
#pragma unroll
                    for (int bj = 0; bj < 2; ++bj) { const int h = (u.pn - 4) * 4 + 2 * bj + (wc >> 1); const f32x4 x1 = acc[ai][bj][m][0] * rs, x2 = acc[ai][bj][m][1] * rs;
                        st_bf4(QR + (size_t)row * 512 + h * 64 + i0, x1 * cs - x2 * sn); st_bf4(QR + (size_t)row * 512 + h * 64 + 32 + i0, x2 * cs + x1 * sn); }
                } else {
                    bf16* D = isq ? QN + u.pn * 256 : (u.pn < 4 ? KN + u.pn * 256 : V + (u.pn - 4) * 256);
#pragma unroll
                    for (int bj = 0; bj < 2; ++bj)
#pragma unroll
                        for (int n = 0; n < 2; ++n) st_bf4(D + (size_t)row * 1024 + bj * 128 + n * 16 + cl, acc[ai][bj][m][n] * rs);
                } }
    }
};

struct OrderP5 {
    int G, c;
    __device__ __forceinline__ bool next(int i, Unit& u) const {
        const int t = (i >> 1) * G + c, half = i & 1; if (t >= 272) return false;
        u.pm = (t >> 3) + 34 * half; u.pn = (t & 7) + 8 * half; return true;
    }
    __device__ __forceinline__ void a_ready(const Unit&) const {}
    __device__ __forceinline__ void done(const Unit&) const {}
};
struct EpiP5 {
    static constexpr bool PERM = false, AFTER_DRAIN = false;
    float* out; unsigned char* ws;
    __device__ __forceinline__ void operator()(f32x4 (&acc)[2][2][4][2], const Unit& u0, int wr, int wc, int fr, int fq) const {
        const int half = u0.pn >= 8; Unit u; u.pm = u0.pm - 34 * half; u.pn = u0.pn - 8 * half;
        const bf16* Gt = (const bf16*)(ws + WS_G) + half * 2048 + u.pn * 256; float* M1 = out + u.pn * 256; bf16* M = (bf16*)(ws + WS_AGATE) + u.pn * 256;
        const int cl = wc * 32 + 4 * fq;
#pragma unroll
        for (int ai = 0; ai < 2; ++ai)
#pragma unroll
            for (int m = 0; m < 4; ++m) { int row = EPI_ROWS(ai, m); asm volatile("" : "+v"(row) :: "memory");
#pragma unroll
                for (int bj = 0; bj < 2; ++bj)
#pragma unroll
                    for (int n = 0; n < 2; ++n) { const int c = bj * 128 + n * 16 + cl;
                        const u32x2 gw = *(const GAS u32x2*)(Gt + (size_t)row * 4096 + c);
                        f32x4 g; g.x = __builtin_bit_cast(float, gw.x << 16); g.y = __builtin_bit_cast(float, gw.x & 0xffff0000u); g.z = __builtin_bit_cast(float, gw.y << 16); g.w = __builtin_bit_cast(float, gw.y & 0xffff0000u);
                        f32x4 v = acc[ai][bj][m][n] * g;
                        if (half == 0) st_f4(M1 + (size_t)row * DM + c, v);
                        else { v += *(const GAS f32x4*)(M1 + (size_t)row * DM + c); st_bf4(M + (size_t)row * DM + c, v); } } }
    }
};

struct EpiP6 {
    static constexpr bool PERM = false, AFTER_DRAIN = false;
    float* out; unsigned char* ws; const float* xp; const float* xs;
    __device__ __forceinline__ void operator()(f32x4 (&acc)[2][2][4][2], const Unit& u, int wr, int wc, int fr, int fq) const {
        float* SS = (float*)(ws + WS_SSQH); const int cl = wc * 32 + 4 * fq;
#pragma unroll
        for (int ai = 0; ai < 2; ++ai)
#pragma unroll
            for (int m = 0; m < 4; ++m) { int row = EPI_ROWS(ai, m); asm volatile("" : "+v"(row) :: "memory"); const float* xr = (row < RP ? xp + (size_t)row * DM : xs + (size_t)(row - RP) * DM) + u.pn * 256; float s = 0.f;
#pragma unroll
                for (int bj = 0; bj < 2; ++bj)
#pragma unroll
                    for (int n = 0; n < 2; ++n) { const int c = bj * 128 + n * 16 + cl; const f32x4 v = acc[ai][bj][m][n] + *(const GAS f32x4*)(xr + c);
                        s += (v.x * v.x + v.y * v.y) + (v.z * v.z + v.w * v.w); st_f4(out + (size_t)row * DM + u.pn * 256 + c, v); }
                s += __shfl_xor(s, 16); s += __shfl_xor(s, 32);
                if (fq == 0) SS[(size_t)row * 32 + u.pn * 4 + wc] = s; }
    }
};

__device__ __forceinline__ int crow(int r, int hi) { return (r & 3) + 8 * (r >> 2) + 4 * hi; }
__device__ __forceinline__ size_t tri_off(int b, int c) { return (size_t)b * TRI_B + 4096ull * (size_t)(c * (c + 3) / 2); }
__device__ __forceinline__ int tri_stride(int c) { return c >= 31 ? 2048 : (c + 2) * 64; }
constexpr int IQ_LDS_STRIDE = 2064;

__device__ __forceinline__ void idx_unit(Frame& F, int set, int b, int c, int sub) {
    const int lane = F.lane, wid = F.wave, r32 = lane & 31, hi = lane >> 5;
    const int row0 = set == 0 ? b * 2048 + c * 64 + sub * 32 : RP + b * 32;
    const int krow0 = set == 0 ? b * 2048 : RP + b * LSP;
    const int nkeys = set == 0 ? (c + 1) * 64 : LS;
    const int stride = set == 0 ? tri_stride(c) : LSP;
    float* brow0 = set == 0 ? (float*)(F.ws + WS_BIAS_P) + tri_off(b, c) + (size_t)(sub * 32) * stride : (float*)(F.ws + WS_BIAS_S) + (size_t)(b * 32) * LSP;
    const bf16* IQ = (const bf16*)(F.ws + WS_IQ); const bf16* IKC = (const bf16*)(F.ws + WS_IKC); const float* IW = (const float*)(F.ws + WS_IW);
    LAS unsigned char* L = F.lds + RING_OFF;
#pragma unroll
    for (int i = 0; i < 8; ++i) { const int id = F.tid + 512 * i, r = id >> 7, ch = id & 127;
        const v4u v = *(const GAS v4u*)(IQ + (size_t)(row0 + r) * 1024 + ch * 8); *(LAS v4u*)(L + r * IQ_LDS_STRIDE + ch * 16) = v; }
    LAS float* WL = (LAS float*)(L + 32 * IQ_LDS_STRIDE);
    { const int q = F.tid >> 4, h = F.tid & 15; WL[q * 17 + h] = IW[(size_t)(row0 + q) * 16 + h]; }
    __syncthreads();
    const int nkt = nkeys >> 5;
    for (int kt = wid; kt < nkt; kt += NWAVES) {
        const int k0 = kt * 32;
        bf16x8 kf[4];
#pragma unroll
        for (int ks = 0; ks < 4; ++ks) kf[ks] = *(const GAS bf16x8*)(IKC + (size_t)(krow0 + k0 + r32) * 64 + ks * 16 + hi * 8);
        f32x16 sc = {};
#pragma unroll 2
        for (int h = 0; h < 16; ++h) { f32x16 d = {}; const float w = WL[r32 * 17 + h];
#pragma unroll
            for (int ks = 0; ks < 4; ++ks) { const bf16x8 bq = *(const LAS bf16x8*)(L + r32 * IQ_LDS_STRIDE + h * 128 + (ks * 16 + hi * 8) * 2); d = __builtin_amdgcn_mfma_f32_32x32x16_bf16(kf[ks], bq, d, 0, 0, 0); }
#pragma unroll
            for (int r = 0; r < 16; ++r) sc[r] += w * fmaxf(d[r], 0.f); }
        float* br = brow0 + (size_t)r32 * stride + k0 + 4 * hi;
#pragma unroll
        for (int a = 0; a < 4; ++a) { f32x4 v = {sc[4 * a], sc[4 * a + 1], sc[4 * a + 2], sc[4 * a + 3]}; *(GAS f32x4*)(br + 8 * a) = v; }
    }
    VM_WAIT(); __syncthreads();
    const int K = 256;
    for (int qi = 0; qi < 4; ++qi) {
        float* br = brow0 + (size_t)(wid * 4 + qi) * stride;
        unsigned uk[34];
#pragma unroll
        for (int i = 0; i < 34; ++i) { const int idx = lane + 64 * i; unsigned u = 0u;
            if (idx < nkeys) { const unsigned bits = __builtin_bit_cast(unsigned, br[idx]); u = bits ^ ((unsigned)((int)bits >> 31) | 0x80000000u); }
            uk[i] = u; }
        unsigned prefix = 0u;
        if (nkeys > K) {
            for (int bit = 31; bit >= 0; --bit) { const unsigned cand = prefix | (1u << bit); int cnt = 0;
#pragma unroll
                for (int i = 0; i < 34; ++i) cnt += (uk[i] >= cand) ? 1 : 0;
#pragma unroll
                for (int o = 1; o < 64; o <<= 1) cnt += __shfl_xor(cnt, o);
                if (cnt >= K) prefix = cand;
                if (cnt == K) break; }
        }
#pragma unroll
        for (int i = 0; i < 34; ++i) { const int idx = lane + 64 * i; if (idx < stride) br[idx] = (idx < nkeys && uk[i] >= prefix) ? 0.f : NEG_INF; }
    }
    VM_WAIT(); __syncthreads();
}

__device__ __forceinline__ void ckv_norm(Frame& F) {
    const int gw = F.vcu * NWAVES + F.wave, NGW = F.G * NWAVES; const float* SS = (const float*)(F.ws + WS_SSQKV); const float* g = F.in[I_KVNG]; bf16* KCAT = (bf16*)(F.ws + WS_KCAT);
    for (int m = gw; m < RT; m += NGW) {
        float* p = m < RP ? F.out + O_PCKV + (size_t)m * 512 : F.out + O_SCKV + (size_t)(m - RP) * 512;
        const f32x4 s0 = *(const GAS f32x4*)(SS + (size_t)m * 8), s1 = *(const GAS f32x4*)(SS + (size_t)m * 8 + 4);
        const float rs = 1.0f / sqrtf(((s0.x + s0.y) + (s0.z + s0.w) + (s1.x + s1.y) + (s1.z + s1.w)) * (1.f / 512.f) + EPS);
#pragma unroll
        for (int j = 0; j < 2; ++j) { const int c = (F.lane + 64 * j) * 4; const f32x4 gg = *(const GAS f32x4*)(g + c); f32x4 v = *(const GAS f32x4*)(p + c); v = v * rs * gg; *(GAS f32x4*)(p + c) = v;
            if (m >= RP) st_bf4(KCAT + (size_t)(krow_of(m) - RP) * 576 + c, v); }
    }
}

namespace att {
constexpr int SHM_V = 16384, SHM_K = 16384, SHM_KR = 8192, KVBLK = 64;
constexpr int OFF_V = 0, OFF_K = 2 * SHM_V, OFF_KR = OFF_K + 2 * SHM_K, OFF_WS = OFF_KR + 2 * SHM_KR, BYTES = OFF_WS + 8 * 64 * 4;
#define KSWZ(row, colB) ((row) * 256 + ((colB) ^ (((row) & 7) << 4)))
#define KRSWZ(row, colB) ((row) * 128 + ((colB) ^ (((row) & 7) << 4)))
#define SBAR() __builtin_amdgcn_sched_barrier(0)

__device__ __forceinline__ void partialSM(f32x16& p0, f32x16& p1, float& m_reg, float& mn, float& alpha, float C, float thr) {
    float pmax = p0[0];
#pragma unroll
    for (int r = 1; r < 16; ++r) pmax = fmaxf(pmax, p0[r]);
#pragma unroll
    for (int r = 0; r < 16; ++r) pmax = fmaxf(pmax, p1[r]);
    { auto rr = __builtin_amdgcn_permlane32_swap(__float_as_uint(pmax), __float_as_uint(pmax), false, false); pmax = fmaxf(__uint_as_float(rr[0]), __uint_as_float(rr[1])); }
    if (__builtin_expect(__all(pmax - m_reg <= thr), 1)) { mn = m_reg; alpha = 1.f; }
    else { mn = fmaxf(m_reg, pmax); alpha = __builtin_amdgcn_exp2f((m_reg - mn) * C); m_reg = mn; }
    const float mnC = -mn * C;
#pragma unroll
    for (int r = 0; r < 16; ++r) p0[r] = fmaf(p0[r], C, mnC);
#pragma unroll
    for (int r = 0; r < 16; ++r) p1[r] = fmaf(p1[r], C, mnC);
#pragma unroll
    for (int r = 0; r < 16; ++r) p0[r] = __builtin_amdgcn_exp2f(p0[r]);
}
__device__ __forceinline__ void finishSM(f32x16& p0, f32x16& p1, float alpha, float& l_reg, bf16x8& pa0, bf16x8& pa1, bf16x8& pa2, bf16x8& pa3) {
#pragma unroll
    for (int r = 0; r < 16; ++r) p1[r] = __builtin_amdgcn_exp2f(p1[r]);
    float ps = 0;
#pragma unroll
    for (int r = 0; r < 16; ++r) ps += p0[r];
#pragma unroll
    for (int r = 0; r < 16; ++r) ps += p1[r];
    { auto rr = __builtin_amdgcn_permlane32_swap(__float_as_uint(ps), __float_as_uint(ps), false, false); ps = __uint_as_float(rr[0]) + __uint_as_float(rr[1]); }
    l_reg = l_reg * alpha + ps;
#define PK4(P, BASE, OUT) do { unsigned a0 = cvtpk(P[BASE + 0], P[BASE + 1]), a1 = cvtpk(P[BASE + 2], P[BASE + 3]);   \
    unsigned b0 = cvtpk(P[BASE + 4], P[BASE + 5]), b1 = cvtpk(P[BASE + 6], P[BASE + 7]);                              \
    auto r0 = __builtin_amdgcn_permlane32_swap(a0, b0, false, false); auto r1 = __builtin_amdgcn_permlane32_swap(a1, b1, false, false); \
    v4u w = {r0[0], r1[0], r0[1], r1[1]}; OUT = __builtin_bit_cast(bf16x8, w); } while (0)
    PK4(p0, 0, pa0); PK4(p0, 8, pa1); PK4(p1, 0, pa2); PK4(p1, 8, pa3);
#undef PK4
}
template <bool ROPE>
__device__ __forceinline__ void qkt(f32x16& p0, f32x16& p1, const LAS char* Ks, const LAS char* KRs, const bf16x8* qr, const bf16* qrp, int r32, int hi) {
    bf16x8 qrr[4];
    if constexpr (ROPE) { asm volatile("" : "+v"(qrp));
#pragma unroll
        for (int d0 = 0; d0 < 4; ++d0) qrr[d0] = *(const GAS bf16x8*)(qrp + d0 * 16); }
#pragma unroll
    for (int d0 = 0; d0 < 8; ++d0) { const int cb = (d0 * 16 + hi * 8) * 2;
        const bf16x8 b0 = *(const LAS bf16x8*)(Ks + KSWZ(r32, cb)); const bf16x8 b1 = *(const LAS bf16x8*)(Ks + KSWZ(32 + r32, cb));
        p0 = __builtin_amdgcn_mfma_f32_32x32x16_bf16(b0, qr[d0], p0, 0, 0, 0); p1 = __builtin_amdgcn_mfma_f32_32x32x16_bf16(b1, qr[d0], p1, 0, 0, 0); }
    if constexpr (ROPE) {
#pragma unroll
        for (int d0 = 0; d0 < 4; ++d0) { const int cb = (d0 * 16 + hi * 8) * 2;
            const bf16x8 b0 = *(const LAS bf16x8*)(KRs + KRSWZ(r32, cb)); const bf16x8 b1 = *(const LAS bf16x8*)(KRs + KRSWZ(32 + r32, cb));
            p0 = __builtin_amdgcn_mfma_f32_32x32x16_bf16(b0, qrr[d0], p0, 0, 0, 0); p1 = __builtin_amdgcn_mfma_f32_32x32x16_bf16(b1, qrr[d0], p1, 0, 0, 0); }
    }
}
__device__ __forceinline__ int v_st(int k, int c) { const int kk = (k & ~0xC) | ((k & 4) << 1) | ((k & 8) >> 1); return ((kk >> 3) * 4 + (c >> 5)) * 512 + ((kk & 7) * 32 + (c & 31)) * 2; }
__device__ __forceinline__ int v_rd_base(int lane) { return ((lane & 3) << 3) | (((lane >> 2) & 3) << 6) | (((lane >> 4) & 1) << 5) | (((lane >> 5) & 1) << 8); }
constexpr int v_rd_off(int d0, int ks, int half) { return d0 * 512 + ks * 4096 + half * 2048; }
template <int OFF> __device__ __forceinline__ s16x4 tr_read(int vb) { s16x4 r; asm volatile("ds_read_b64_tr_b16 %0, %1 offset:%2" : "=&v"(r) : "v"(vb), "i"(OFF) : "memory"); return r; }
template <int D0> __device__ __forceinline__ void pv_one(f32x16& od, int vb, bf16x8 pa0, bf16x8 pa1, bf16x8 pa2, bf16x8 pa3) {
    const s16x4 l0 = tr_read<v_rd_off(D0, 0, 0)>(vb), h0 = tr_read<v_rd_off(D0, 0, 1)>(vb), l1 = tr_read<v_rd_off(D0, 1, 0)>(vb), h1 = tr_read<v_rd_off(D0, 1, 1)>(vb);
    const s16x4 l2 = tr_read<v_rd_off(D0, 2, 0)>(vb), h2 = tr_read<v_rd_off(D0, 2, 1)>(vb), l3 = tr_read<v_rd_off(D0, 3, 0)>(vb), h3 = tr_read<v_rd_off(D0, 3, 1)>(vb);
    asm volatile("s_waitcnt lgkmcnt(0)" ::: "memory"); SBAR();
#define PKV(L, H) (bf16x8){L[0], L[1], L[2], L[3], H[0], H[1], H[2], H[3]}
    od = __builtin_amdgcn_mfma_f32_32x32x16_bf16(pa0, PKV(l0, h0), od, 0, 0, 0);
    od = __builtin_amdgcn_mfma_f32_32x32x16_bf16(pa1, PKV(l1, h1), od, 0, 0, 0);
    od = __builtin_amdgcn_mfma_f32_32x32x16_bf16(pa2, PKV(l2, h2), od, 0, 0, 0);
    od = __builtin_amdgcn_mfma_f32_32x32x16_bf16(pa3, PKV(l3, h3), od, 0, 0, 0);
#undef PKV
}
__device__ __forceinline__ void pv_d0(f32x16* o, int vb, bf16x8 pa0, bf16x8 pa1, bf16x8 pa2, bf16x8 pa3) {
    pv_one<0>(o[0], vb, pa0, pa1, pa2, pa3); pv_one<1>(o[1], vb, pa0, pa1, pa2, pa3); pv_one<2>(o[2], vb, pa0, pa1, pa2, pa3); pv_one<3>(o[3], vb, pa0, pa1, pa2, pa3);
}

template <bool ROPE, bool BIAS>
__device__ __forceinline__ void attn_body(const bf16* Qrow, const bf16* QRrow, const float* biasrow, int jmax, const bf16* __restrict__ Kh, const bf16* __restrict__ Vh, int ldk,
                                          const bf16* __restrict__ KRh, int NT, float C, bf16* Ow, const bf16* Gw, bool active, LAS char* lds) {
    const int tid = threadIdx.x, lane = tid & 63, r32 = lane & 31, hi = lane >> 5; const int wid = __builtin_amdgcn_readfirstlane(tid >> 6);
    LAS char* V_lds = lds + OFF_V; LAS char* K_lds = lds + OFF_K; LAS char* KR_lds = lds + OFF_KR;
    LAS float* wsf = (LAS float*)(lds + OFF_WS) + wid * 64; LAS float* li_l = wsf; LAS float* al_l = wsf + 32;
    const float thr = 8.f * LOG2E / C;
    float m_reg = -1e30f, l_reg = 0; f32x16 o[4] = {}; bf16x8 qr[8];
#pragma unroll
    for (int d0 = 0; d0 < 8; ++d0) qr[d0] = *(const GAS bf16x8*)(Qrow + d0 * 16 + hi * 8);
    const bf16* qrp0 = ROPE ? QRrow + hi * 8 : nullptr;
    const int sr = tid >> 4, sc = (tid & 15) * 8, vst0 = v_st(sr, sc), vst1 = v_st(32 + sr, sc);
    const int krr = tid >> 3, krc = (tid & 7) * 8;
    const int vb0 = (int)(uintptr_t)V_lds + v_rd_base(lane);
    const bf16* kp = Kh + (size_t)sr * ldk + sc; const bf16* vp = Vh + (size_t)sr * ldk + sc; const bf16* krp = ROPE ? KRh + (size_t)krr * 64 + krc : nullptr;
    const size_t tstep = (size_t)64 * ldk, hstep = (size_t)32 * ldk;
    struct { bf16x8 vs0, vs1, ks0, ks1, kr; } st;
#define SLOAD() do { st.vs0 = *(const GAS bf16x8*)vp; st.vs1 = *(const GAS bf16x8*)(vp + hstep); st.ks0 = *(const GAS bf16x8*)kp; st.ks1 = *(const GAS bf16x8*)(kp + hstep); \
    if constexpr (ROPE) { st.kr = *(const GAS bf16x8*)krp; krp += 64 * 64; } kp += tstep; vp += tstep; } while (0)
#define SWRITE(b) do { *(LAS bf16x8*)(V_lds + (b) * SHM_V + vst0) = st.vs0; *(LAS bf16x8*)(V_lds + (b) * SHM_V + vst1) = st.vs1; const int kc = sc * 2; \
    *(LAS bf16x8*)(K_lds + (b) * SHM_K + KSWZ(sr, kc)) = st.ks0; *(LAS bf16x8*)(K_lds + (b) * SHM_K + KSWZ(32 + sr, kc)) = st.ks1; \
    if constexpr (ROPE) *(LAS bf16x8*)(KR_lds + (b) * SHM_KR + KRSWZ(krr, krc * 2)) = st.kr; } while (0)
    SLOAD(); SWRITE(0); __syncthreads();
    for (int j = 0; j < NT; ++j) {
        const int buf = j & 1; const bool more = j + 1 < NT;
        if (more) SLOAD();
        f32x16 p0, p1;
        if constexpr (BIAS) { const float* bp = biasrow + j * 64 + 4 * hi;
#pragma unroll
            for (int a = 0; a < 4; ++a) { const f32x4 t0 = *(const GAS f32x4*)(bp + 8 * a), t1 = *(const GAS f32x4*)(bp + 32 + 8 * a);
                p0[4 * a] = t0.x; p0[4 * a + 1] = t0.y; p0[4 * a + 2] = t0.z; p0[4 * a + 3] = t0.w; p1[4 * a] = t1.x; p1[4 * a + 1] = t1.y; p1[4 * a + 2] = t1.z; p1[4 * a + 3] = t1.w; }
        } else { const float iv = j > jmax ? NEG_INF : 0.f;
#pragma unroll
            for (int r = 0; r < 16; ++r) { p0[r] = iv; p1[r] = iv; } }
        qkt<ROPE>(p0, p1, K_lds + buf * SHM_K, KR_lds + buf * SHM_KR, qr, qrp0, r32, hi);
        float mn, alpha; partialSM(p0, p1, m_reg, mn, alpha, C, thr);
        if (__any(alpha < 1.f)) { if (hi == 0) al_l[r32] = alpha; asm volatile("s_waitcnt lgkmcnt(0)" ::: "memory");
#pragma unroll
            for (int d = 0; d < 4; ++d)
#pragma unroll
                for (int r = 0; r < 16; ++r) o[d][r] *= al_l[crow(r, hi)]; }
        bf16x8 pa0, pa1, pa2, pa3; finishSM(p0, p1, alpha, l_reg, pa0, pa1, pa2, pa3); SBAR();
        pv_d0(o, vb0 + buf * SHM_V, pa0, pa1, pa2, pa3);
        if (more) SWRITE(buf ^ 1);
        __syncthreads();
    }
    if (hi == 0) li_l[r32] = l_reg; asm volatile("s_waitcnt lgkmcnt(0)" ::: "memory");
    if (active) {
#pragma unroll
        for (int r = 0; r < 16; ++r) { const int orow = crow(r, hi); const float rl = __builtin_amdgcn_rcpf(li_l[orow]);
#pragma unroll
            for (int d0 = 0; d0 < 4; ++d0) { const size_t off = (size_t)orow * 1024 + d0 * 32 + r32; const float g = bf2f(Gw[off]); Ow[off] = (bf16)f2bf(o[d0][r] * rl * g); } }
    }
    __syncthreads();
#undef SLOAD
#undef SWRITE
}
}

namespace smla {
constexpr int KSTR = 1168;
constexpr int OSTR = 1040;
typedef short v4i16_t __attribute__((ext_vector_type(4)));
__device__ __forceinline__ s16x4 vtr(const LAS char* p) { return __builtin_bit_cast(s16x4, __builtin_amdgcn_ds_read_tr16_b64_v4i16((LAS v4i16_t*)p)); }

__device__ __forceinline__ void unit(Frame& F, int b, int hp) {
    const int tid = F.tid, lane = F.lane, wid = F.wave, l15 = lane & 15, G = lane >> 4;
    const int rg = wid & 3, kh = wid >> 2, head = 2 * hp + (rg >> 1), t0 = 16 * (rg & 1);
    const int row = RP + b * 32 + t0 + l15;
    const bf16* QN = (const bf16*)((unsigned char*)F.out + DO_QN); const bf16* QR = (const bf16*)((unsigned char*)F.out + DO_QR);
    const bf16* WUK = (const bf16*)(F.ws + WS_WUK_B); const bf16* WUVT = (const bf16*)(F.ws + WS_WUV_T); const bf16* KCAT = (const bf16*)(F.ws + WS_KCAT) + (size_t)b * LSP * 576;
    LAS char* L = (LAS char*)(F.lds + RING_OFF);
    LAS char* QL = L + 64 * KSTR;
    if (kh == 0) {
        bf16x8 qn[4];
#pragma unroll
        for (int kd = 0; kd < 4; ++kd) qn[kd] = *(const GAS bf16x8*)(QN + (size_t)row * 1024 + head * 128 + kd * 32 + G * 8);
        LAS char* qrow = QL + (16 * rg + l15) * KSTR + G * 16;
#pragma unroll 2
        for (int a = 0; a < 16; ++a) { f32x4 d0 = {0.f, 0.f, 0.f, 0.f}, d1 = {0.f, 0.f, 0.f, 0.f};
#pragma unroll
            for (int kd = 0; kd < 4; ++kd) {
                const bf16x8 w0 = *(const GAS bf16x8*)(WUK + (size_t)(32 * a + l15) * 1024 + head * 128 + kd * 32 + G * 8);
                const bf16x8 w1 = *(const GAS bf16x8*)(WUK + (size_t)(32 * a + 16 + l15) * 1024 + head * 128 + kd * 32 + G * 8);
                d0 = __builtin_amdgcn_mfma_f32_16x16x32_bf16(w0, qn[kd], d0, 0, 0, 0); d1 = __builtin_amdgcn_mfma_f32_16x16x32_bf16(w1, qn[kd], d1, 0, 0, 0); }
#if defined(SMLA_CHK) && SMLA_CHK == 1
            { const float t_ = (d0.x + d0.y) + (d0.z + d0.w) + (d1.x + d1.y) + (d1.z + d1.w); if (!(fabsf(t_) < 3e38f)) F.MISC[6] = 1u; }
#endif
            v4u w; w.x = cvtpk(d0.x, d0.y); w.y = cvtpk(d0.z, d0.w); w.z = cvtpk(d1.x, d1.y); w.w = cvtpk(d1.z, d1.w); *(LAS v4u*)(qrow + a * 64) = w; }
#pragma unroll
        for (int a = 16; a < 18; ++a) { const bf16* qp = QR + (size_t)row * 512 + head * 64 + (a - 16) * 32 + 4 * G;
            const u32x2 lo = *(const GAS u32x2*)qp, hi2 = *(const GAS u32x2*)(qp + 16); v4u w = {lo.x, lo.y, hi2.x, hi2.y}; *(LAS v4u*)(qrow + a * 64) = w;
#if defined(SMLA_CHK) && SMLA_CHK == 10
            if ((w.x & 0x7f80u) == 0x7f80u || (w.x & 0x7f800000u) == 0x7f800000u || (w.y & 0x7f80u) == 0x7f80u || (w.y & 0x7f800000u) == 0x7f800000u || (w.z & 0x7f80u) == 0x7f80u || (w.z & 0x7f800000u) == 0x7f800000u || (w.w & 0x7f80u) == 0x7f80u || (w.w & 0x7f800000u) == 0x7f800000u) F.MISC[6] = 1u;
#endif
            }
    }
    const LAS char* qbase = QL + (16 * rg + l15) * KSTR + G * 16;
#ifdef SMLA_CHK
    if (tid == 0) F.MISC[6] = 0u;
#endif
    f32x4 acc[32];
#pragma unroll
    for (int c = 0; c < 32; ++c) acc[c] = (f32x4){0.f, 0.f, 0.f, 0.f};
    float m_run = -1e30f, l_run = 0.f;
    const float C = SC_MLA;
    const LAS char* kbase = L + (kh * 32 + l15) * KSTR + 8 * G;
    const LAS char* vbase = L + (kh * 32 + 4 * G + (l15 >> 2)) * KSTR + (l15 & 3) * 8;
    for (int kt = 0; kt < 33; ++kt) {
#pragma unroll 1
        for (int i3 = 0; i3 < 3; ++i3) {
#pragma unroll
            for (int i = 0; i < 3; ++i) { const int id = tid + 512 * (3 * i3 + i), r = id / 72, ch = id - r * 72;
                const v4u v = *(const GAS v4u*)(KCAT + (size_t)(kt * 64 + r) * 576 + ch * 8); *(LAS v4u*)(L + r * KSTR + ch * 16) = v;
#if defined(SMLA_CHK) && SMLA_CHK == 8
                { const unsigned e_ = 0x7f807f80u; if ((v.x & 0x7f80u) == 0x7f80u || (v.x & 0x7f800000u) == 0x7f800000u || (v.y & 0x7f80u) == 0x7f80u || (v.y & 0x7f800000u) == 0x7f800000u || (v.z & 0x7f80u) == 0x7f80u || (v.z & 0x7f800000u) == 0x7f800000u || (v.w & 0x7f80u) == 0x7f80u || (v.w & 0x7f800000u) == 0x7f800000u) F.MISC[6] = 1u; (void)e_; }
#endif
                } }
        __syncthreads();
        f32x4 s0 = {0.f, 0.f, 0.f, 0.f}, s1 = {0.f, 0.f, 0.f, 0.f};
#pragma unroll
        for (int a = 0; a < 18; ++a) {
            const u32x2 k00 = *(const LAS u32x2*)(kbase + a * 64), k01 = *(const LAS u32x2*)(kbase + a * 64 + 32);
            const u32x2 k10 = *(const LAS u32x2*)(kbase + 16 * KSTR + a * 64), k11 = *(const LAS u32x2*)(kbase + 16 * KSTR + a * 64 + 32);
            const v4u w0 = {k00.x, k00.y, k01.x, k01.y}, w1 = {k10.x, k10.y, k11.x, k11.y};
            const bf16x8 qfa = *(const LAS bf16x8*)(qbase + a * 64);
#if defined(SMLA_CHK) && SMLA_CHK == 9
            { const v4u w = __builtin_bit_cast(v4u, qfa); if ((w.x & 0x7f80u) == 0x7f80u || (w.x & 0x7f800000u) == 0x7f800000u || (w.y & 0x7f80u) == 0x7f80u || (w.y & 0x7f800000u) == 0x7f800000u || (w.z & 0x7f80u) == 0x7f80u || (w.z & 0x7f800000u) == 0x7f800000u || (w.w & 0x7f80u) == 0x7f80u || (w.w & 0x7f800000u) == 0x7f800000u) F.MISC[6] = 1u; }
#endif
            s0 = __builtin_amdgcn_mfma_f32_16x16x32_bf16(__builtin_bit_cast(bf16x8, w0), qfa, s0, 0, 0, 0);
            s1 = __builtin_amdgcn_mfma_f32_16x16x32_bf16(__builtin_bit_cast(bf16x8, w1), qfa, s1, 0, 0, 0); }
#if defined(SMLA_CHK) && SMLA_CHK == 2
        if (!(fabsf(s0.x) < 3e38f)) F.MISC[6] = 1u; if (!(fabsf(s0.y) < 3e38f)) F.MISC[6] = 1u; if (!(fabsf(s0.z) < 3e38f)) F.MISC[6] = 1u; if (!(fabsf(s0.w) < 3e38f)) F.MISC[6] = 1u; if (!(fabsf(s1.x) < 3e38f)) F.MISC[6] = 1u; if (!(fabsf(s1.y) < 3e38f)) F.MISC[6] = 1u; if (!(fabsf(s1.z) < 3e38f)) F.MISC[6] = 1u; if (!(fabsf(s1.w) < 3e38f)) F.MISC[6] = 1u;
#endif
        if (kt == 32) { if (kh == 1) { s0 = (f32x4){NEG_INF, NEG_INF, NEG_INF, NEG_INF}; s1 = s0; } }
        float tmax = fmaxf(fmaxf(fmaxf(s0.x, s0.y), fmaxf(s0.z, s0.w)), fmaxf(fmaxf(s1.x, s1.y), fmaxf(s1.z, s1.w)));
        tmax = fmaxf(tmax, __shfl_xor(tmax, 16)); tmax = fmaxf(tmax, __shfl_xor(tmax, 32));
        const float m_new = fmaxf(m_run, tmax); const float alpha = __builtin_amdgcn_exp2f((m_run - m_new) * C); const float mC = -m_new * C; m_run = m_new;
        f32x4 p0, p1;
        p0.x = __builtin_amdgcn_exp2f(fmaf(s0.x, C, mC)); p0.y = __builtin_amdgcn_exp2f(fmaf(s0.y, C, mC)); p0.z = __builtin_amdgcn_exp2f(fmaf(s0.z, C, mC)); p0.w = __builtin_amdgcn_exp2f(fmaf(s0.w, C, mC));
        p1.x = __builtin_amdgcn_exp2f(fmaf(s1.x, C, mC)); p1.y = __builtin_amdgcn_exp2f(fmaf(s1.y, C, mC)); p1.z = __builtin_amdgcn_exp2f(fmaf(s1.z, C, mC)); p1.w = __builtin_amdgcn_exp2f(fmaf(s1.w, C, mC));
        float ps = (p0.x + p0.y) + (p0.z + p0.w) + (p1.x + p1.y) + (p1.z + p1.w);
        ps += __shfl_xor(ps, 16); ps += __shfl_xor(ps, 32);
        l_run = l_run * alpha + ps;
#if defined(SMLA_CHK) && SMLA_CHK == 3
        if (!(fabsf(l_run) < 3e38f)) F.MISC[6] = 1u; if (!(fabsf(ps) < 3e38f)) F.MISC[6] = 1u; if (!(fabsf(alpha) < 3e38f)) F.MISC[6] = 1u; if (!(fabsf(m_run) < 3e38f)) F.MISC[6] = 1u;
#endif
        if (__any(alpha < 1.f)) {
            const float a0 = __shfl(alpha, 4 * G), a1 = __shfl(alpha, 4 * G + 1), a2 = __shfl(alpha, 4 * G + 2), a3 = __shfl(alpha, 4 * G + 3); const f32x4 av = {a0, a1, a2, a3};
#pragma unroll
            for (int c = 0; c < 32; ++c) acc[c] *= av; }
        v4u pw; pw.x = cvtpk(p0.x, p0.y); pw.y = cvtpk(p0.z, p0.w); pw.z = cvtpk(p1.x, p1.y); pw.w = cvtpk(p1.z, p1.w); const bf16x8 pf = __builtin_bit_cast(bf16x8, pw);
#pragma unroll
        for (int c = 0; c < 32; ++c) { const s16x4 lo = vtr(vbase + c * 32), hi2 = vtr(vbase + 16 * KSTR + c * 32);
            const bf16x8 vf = (bf16x8){lo[0], lo[1], lo[2], lo[3], hi2[0], hi2[1], hi2[2], hi2[3]};
            acc[c] = __builtin_amdgcn_mfma_f32_16x16x32_bf16(pf, vf, acc[c], 0, 0, 0); }
        __syncthreads();
    }
#if defined(SMLA_CHK) && SMLA_CHK == 4
    { float t_ = 0.f; _Pragma("unroll") for (int c = 0; c < 32; ++c) t_ += (acc[c].x + acc[c].y) + (acc[c].z + acc[c].w); if (!(fabsf(t_) < 3e38f)) F.MISC[6] = 1u; }
#endif
    LAS float* ST = (LAS float*)L;
    LAS float* FAC = (LAS float*)(L + 1024);
    if (G == 0) { ST[(wid * 16 + l15) * 2] = m_run; ST[(wid * 16 + l15) * 2 + 1] = l_run; }
    __syncthreads();
    { const float mo = ST[((wid ^ 4) * 16 + l15) * 2], lo = ST[((wid ^ 4) * 16 + l15) * 2 + 1];
      const float mf = fmaxf(m_run, mo); const float e_me = __builtin_amdgcn_exp2f((m_run - mf) * C), e_ot = __builtin_amdgcn_exp2f((mo - mf) * C);
      const float fac = e_me / (l_run * e_me + lo * e_ot);
      if (G == 0) FAC[wid * 16 + l15] = fac; }
    __syncthreads();
    { const f32x4 fv = {FAC[wid * 16 + 4 * G], FAC[wid * 16 + 4 * G + 1], FAC[wid * 16 + 4 * G + 2], FAC[wid * 16 + 4 * G + 3]};
#pragma unroll
      for (int c = 0; c < 32; ++c) acc[c] *= fv; }
    __syncthreads();
    LAS f32x4* XB = (LAS f32x4*)L;
#pragma unroll
    for (int half = 0; half < 2; ++half) {
        if (kh == 1) {
#pragma unroll
            for (int c = 0; c < 16; ++c) XB[(rg * 16 + c) * 64 + lane] = acc[half * 16 + c]; }
        __syncthreads();
        if (kh == 0) {
#pragma unroll
            for (int c = 0; c < 16; ++c) acc[half * 16 + c] += XB[(rg * 16 + c) * 64 + lane]; }
        __syncthreads();
    }
#if defined(SMLA_CHK) && SMLA_CHK == 5
    if (kh == 0) { float t_ = 0.f; _Pragma("unroll") for (int c = 0; c < 32; ++c) t_ += (acc[c].x + acc[c].y) + (acc[c].z + acc[c].w); if (!(fabsf(t_) < 3e38f)) F.MISC[6] = 1u; }
#endif
    if (kh == 0) {
#pragma unroll
        for (int c = 0; c < 32; ++c) {
            LAS unsigned short* op = (LAS unsigned short*)(L + (16 * rg + 4 * G) * OSTR + (16 * c + l15) * 2);
            op[0] = (unsigned short)f2bf(acc[c].x); op[OSTR / 2] = (unsigned short)f2bf(acc[c].y); op[2 * (OSTR / 2)] = (unsigned short)f2bf(acc[c].z); op[3 * (OSTR / 2)] = (unsigned short)f2bf(acc[c].w); }
    }
    __syncthreads();
    {   const int hh = wid >> 2, rt = (wid >> 1) & 1, cb0 = 4 * (wid & 1), hd = 2 * hp + hh;
        f32x4 d[4];
#pragma unroll
        for (int j = 0; j < 4; ++j) d[j] = (f32x4){0.f, 0.f, 0.f, 0.f};
#pragma unroll 4
        for (int ks = 0; ks < 16; ++ks) {
            const bf16x8 af = *(const LAS bf16x8*)(L + (32 * hh + 16 * rt + l15) * OSTR + (32 * ks + 8 * G) * 2);
#pragma unroll
            for (int j = 0; j < 4; ++j) { const bf16x8 bfr = *(const GAS bf16x8*)(WUVT + (size_t)(hd * 128 + 16 * (cb0 + j) + l15) * 512 + 32 * ks + 8 * G);
                d[j] = __builtin_amdgcn_mfma_f32_16x16x32_bf16(af, bfr, d[j], 0, 0, 0); } }
        const bf16* BG = (const bf16*)(F.ws + WS_BGATE); bf16* OB = (bf16*)(F.ws + WS_IQ);
#pragma unroll
        for (int j = 0; j < 4; ++j)
#pragma unroll
            for (int i = 0; i < 4; ++i) { const size_t off = (size_t)(RP + b * 32 + 16 * rt + 4 * G + i) * 1024 + hd * 128 + 16 * (cb0 + j) + l15;
#ifdef SMLA_CHK
#if SMLA_CHK == 6
                if (!(fabsf(d[j][i]) < 3e38f)) F.MISC[6] = 1u;
#endif
#if SMLA_CHK == 7
                if (!(fabsf(bf2f(BG[off])) < 3e38f)) F.MISC[6] = 1u;
#endif
                OB[off] = F.MISC[6] ? (bf16)0x7fc0 : (bf16)0;
#else
                OB[off] = (bf16)f2bf(d[j][i] * bf2f(BG[off]));
#endif
                }
    }
    __syncthreads();
}
}

constexpr int N_U4A = 64, N_U4 = 32 + 512;
__device__ __forceinline__ void p4_unit(Frame& F, int u) {
    LAS char* L = (LAS char*)(F.lds + RING_OFF);
    const int lane = F.lane, wid = F.wave, r32 = lane & 31, hi = lane >> 5;
#ifndef P4_MASK
#define P4_MASK 7
#endif
    const bf16* AQ = (const bf16*)(F.ws + WS_AQ); const bf16* AKC = (const bf16*)(F.ws + WS_AKC); const bf16* AVC = (const bf16*)(F.ws + WS_AVC); const bf16* AG = (const bf16*)(F.ws + WS_AGATE);
    if (u < 32) { if (!(P4_MASK & 2)) return;
        const int b = u >> 1, g = u & 1, head = 4 * g + (wid & 3); const int row0 = RP + b * 32;
        const size_t qoff = (size_t)row0 * 1024 + head * 128;
        att::attn_body<false, true>(AQ + qoff + (size_t)r32 * 1024, nullptr, (const float*)(F.ws + WS_BIAS_S) + (size_t)(b * 32 + r32) * LSP, 1 << 30,
                                    AKC + (size_t)(RP + b * LSP) * 256 + g * 128, AVC + (size_t)(RP + b * LSP) * 256 + g * 128, 256, nullptr, 33, SC_DSA,
                                    (bf16*)(F.ws + WS_AQ) + qoff, AG + qoff, wid < 4, L);
        return; }
    u -= 32;
    const int r = 7 - (u >> 6), v = u & 63;
    if (v < 32) { if (!(P4_MASK & 4)) return;
        const int b = v >> 3, h = v & 7, qb = r; const int row0 = b * 2048 + qb * 256 + wid * 32;
        const bf16* QN = (const bf16*)((unsigned char*)F.out + DO_QN); const bf16* QR = (const bf16*)((unsigned char*)F.out + DO_QR);
        const bf16* KN = (const bf16*)((unsigned char*)F.out + DO_KN); const bf16* VV = (const bf16*)((unsigned char*)F.out + DO_V); const bf16* KRP = (const bf16*)(F.ws + WS_KRP);
        const size_t qoff = (size_t)row0 * 1024 + h * 128;
        att::attn_body<true, false>(QN + qoff + (size_t)r32 * 1024, QR + (size_t)(row0 + r32) * 512 + h * 64, nullptr, 4 * qb + (wid >> 1),
                                    KN + (size_t)(b * 2048) * 1024 + h * 128, VV + (size_t)(b * 2048) * 1024 + h * 128, 1024, KRP + (size_t)(b * 2048) * 64, 4 * (qb + 1), SC_MLA,
                                    (bf16*)(F.ws + WS_IQ) + qoff, (const bf16*)(F.ws + WS_BGATE) + qoff, true, L);
    } else { if (!(P4_MASK & 2)) return;
        const int w2 = v - 32, c = 4 * r + 3 - (w2 >> 3), b = (w2 >> 1) & 3, g = w2 & 1, head = 4 * g + (wid & 3), sub = wid >> 2;
        const int row0 = b * 2048 + c * 64 + sub * 32; const size_t qoff = (size_t)row0 * 1024 + head * 128;
        const float* bias = (const float*)(F.ws + WS_BIAS_P) + tri_off(b, c) + (size_t)(sub * 32 + r32) * tri_stride(c);
        att::attn_body<false, true>(AQ + qoff + (size_t)r32 * 1024, nullptr, bias, 1 << 30,
                                    AKC + (size_t)(b * 2048) * 256 + g * 128, AVC + (size_t)(b * 2048) * 256 + g * 128, 256, nullptr, c + 1, SC_DSA,
                                    (bf16*)(F.ws + WS_AQ) + qoff, AG + qoff, true, L);
    }
    (void)hi;
}
constexpr int N_U3 = 16 + 256;
__device__ __forceinline__ void p3_unit(Frame& F, int u) {
    if (u < 16) { idx_unit(F, 1, u, 0, 0); return; }
    const int v = u - 16, c = 31 - (v >> 3), b = (v >> 1) & 3, sub = v & 1;
    idx_unit(F, 0, b, c, sub);
}
__device__ __forceinline__ int dequeue(Frame& F, gu32* ctr) {
    if (F.tid == 0) F.MISC[4] = __hip_atomic_fetch_add(ctr, 1u, RLX_AGENT);
    __syncthreads();
    const int u = (int)F.MISC[4];
    __syncthreads();
    return u;
}

__device__ __forceinline__ void p7_final(Frame& F) {
    const int gw = F.vcu * NWAVES + F.wave, NGW = F.G * NWAVES; const float* SS = (const float*)(F.ws + WS_SSQH); const GAS f32x4* gr = (const GAS f32x4*)F.in[I_FG] + F.lane;
    for (int m = gw; m < RT; m += NGW) {
        float s = 0.f; if (F.lane < 32) s = SS[(size_t)m * 32 + F.lane];
        const float rs = 1.0f / sqrtf(wave_sum(s) * (1.f / DM) + EPS);
        GAS f32x4* p = (GAS f32x4*)(F.out + (size_t)m * DM) + F.lane;
#pragma unroll
        for (int j = 0; j < 8; ++j) { const f32x4 v = p[64 * j] * rs * gr[64 * j]; p[64 * j] = v; }
    }
}

#ifndef MK_N_LAUNCHES
#define MK_N_LAUNCHES 1
#endif
constexpr int N_PHASES = 8;
struct Args { const float* in[18]; float* out; unsigned char* ws; int ph_lo, ph_hi; };
__global__ void __launch_bounds__(NWAVES * 64, 2) mk_fwd(Args args) {
    extern __shared__ __attribute__((aligned(16))) unsigned char lds[];
    Frame F;
    F.lds = (LAS unsigned char*)lds; F.MISC = (volatile LAS unsigned*)(F.lds + MISC_OFF);
    F.tid = threadIdx.x; F.lane = F.tid & 63; F.wave = __builtin_amdgcn_readfirstlane(F.tid >> 6);
    F.G = gridDim.x; { const int bx = blockIdx.x; F.vcu = (F.G % 8 == 0) ? (bx % 8) * (F.G / 8) + bx / 8 : bx; }
    F.ws = args.ws; F.out = args.out; F.ctl = (gu32*)(args.ws + WS_CTL);
#pragma unroll
    for (int i = 0; i < 18; ++i) F.in[i] = args.in[i];
    for (int u = F.tid; u < (LDS_BYTES - LDSCTL_OFF) / 4; u += NWAVES * 64) ((LAS unsigned*)(F.lds + LDSCTL_OFF))[u] = 0u;
    __syncthreads();
    const int lo = args.ph_lo, hi = args.ph_hi;
    XcdBarrier bar; bar.bar = (unsigned*)(F.ctl + CW_BAR); bar.x = 0; bar.st = nullptr;
    if (hi - lo > 1) bar = xcd_barrier_post((unsigned*)(F.ctl + CW_BAR), F.MISC + 8);
#ifndef PH_MASK
#define PH_MASK 255
#endif
#define IN(k) (((PH_MASK >> (k)) & 1) && lo <= (k) && (k) < hi)
#define SEAM(k) do { if (IN(k) && IN((k) + 1)) xcd_barrier(bar); } while (0)

    if (IN(0)) { p0_prologue(F); SEAM(0); }
    if (IN(1)) {
        pg8::Gemm g{(const bf16*)((unsigned char*)F.out + DO_XN), (const bf16*)(F.ws + WS_WIN_T), RT, PROJP, DM}; pg8::StaticOrder S; S.init(RT, PROJP, F.G, (int)blockIdx.x);
        EpiInProj E{F.out, F.ws};
        pg8::gemm_phase<EpiInProj, pg8::StaticOrder, true, true>(F.lds + RING_OFF, g, S, E);
        SEAM(1);
    }
    if (IN(2)) {
        pg8::Gemm g{(const bf16*)(F.ws + WS_CQ), (const bf16*)(F.ws + WS_WUQ_T), 0, 0, 512}; OrderP2 S{F.G, (int)blockIdx.x};
        EpiP2 E{F.out, F.ws};
        pg8::gemm_phase<EpiP2, OrderP2, true, true>(F.lds + RING_OFF, g, S, E);
        SEAM(2);
    }
    if (IN(3)) {
        ckv_norm(F);
        for (;;) { const int u = dequeue(F, F.ctl + CW_Q3); if (u >= N_U3) break; p3_unit(F, u); }
        SEAM(3);
    }
    if (IN(4)) {
        for (;;) { const int u = dequeue(F, F.ctl + CW_Q4A); if (u >= N_U4A) break; smla::unit(F, u >> 2, u & 3); }
        for (;;) { const int u = dequeue(F, F.ctl + CW_Q4); if (u >= N_U4) break; p4_unit(F, u); }
        SEAM(4);
    }
#ifdef DBG_MODE
    if (IN(5)) {
        const bf16* OB = (const bf16*)(F.ws + WS_IQ); const long gt = (long)F.vcu * 512 + F.tid, NGT = (long)F.G * 512;
        for (long i = gt; i < (long)RT * DM; i += NGT) { const long row = i >> 11, col = i & 2047; float v = 0.f;
            const bool sel = (DBG_MODE & 1) ? (row < RP) : (row >= RP);
            if (sel && col < 1024) { const float x = bf2f(OB[row * 1024 + col]); if (DBG_MODE < 3) v = (x == x && fabsf(x) < 3e38f) ? 0.f : __builtin_nanf(""); else v = x; }
            F.out[i] = v; }
    }
#else
    if (IN(5)) {
        pg8::Gemm g{(const bf16*)(F.ws + WS_AQ), (const bf16*)(F.ws + WS_WOA_T), 0, 0, 1024}; OrderP5 S{F.G, (int)blockIdx.x};
        EpiP5 E{F.out, F.ws};
        pg8::gemm_phase<EpiP5, OrderP5, true, true>(F.lds + RING_OFF, g, S, E);
        SEAM(5);
    }
#endif
    if (IN(6)) {
        pg8::Gemm g{(const bf16*)(F.ws + WS_AGATE), (const bf16*)(F.ws + WS_WOUT_T), RT, DM, DM}; pg8::StaticOrder S; S.init(RT, DM, F.G, (int)blockIdx.x);
        EpiP6 E{F.out, F.ws, F.in[I_XP], F.in[I_XS]};
        pg8::gemm_phase<EpiP6, pg8::StaticOrder, true, true>(F.lds + RING_OFF, g, S, E);
        SEAM(6);
    }
    if (IN(7)) p7_final(F);

#undef IN
#undef SEAM
}

extern "C" void kernel_launch(void* const* d_in, const int* in_sizes, int n_in, void* d_out, int out_size, void* d_ws, size_t ws_size, hipStream_t stream) {
    static int grid = 0;
    if (grid == 0) {
        if (n_in != 18 || out_size != (int)O_END || ws_size < WS_END) { fprintf(stderr, "kernel_launch: unexpected shapes: n_in %d out %d ws %zu (need %zu)\n", n_in, out_size, ws_size, (size_t)WS_END); grid = -1; return; }
        int dev = 0, cus = 0;
        if (hipGetDevice(&dev) != hipSuccess || hipDeviceGetAttribute(&cus, hipDeviceAttributeMultiprocessorCount, dev) != hipSuccess) { grid = -1; return; }
        if (hipFuncSetAttribute((const void*)mk_fwd, hipFuncAttributeMaxDynamicSharedMemorySize, LDS_BYTES) != hipSuccess) { fprintf(stderr, "kernel_launch: hipFuncSetAttribute failed\n"); grid = -1; return; }
        int per_cu = 0;
        if (hipOccupancyMaxActiveBlocksPerMultiprocessor(&per_cu, (const void*)mk_fwd, NWAVES * 64, LDS_BYTES) != hipSuccess || per_cu < 1) fprintf(stderr, "kernel_launch: occupancy query says %d blocks per CU\n", per_cu);
        (void)hipGetLastError();
        grid = cus;
    }
    if (grid < 0) return;
    (void)hipMemsetAsync((char*)d_ws + WS_CTL, 0, CTL_ZERO_BYTES, stream);
    Args a{};
    for (int i = 0; i < 18; ++i) a.in[i] = (const float*)d_in[i];
    a.out = (float*)d_out; a.ws = (unsigned char*)d_ws;
#if MK_N_LAUNCHES == 1
    a.ph_lo = 0; a.ph_hi = N_PHASES;
    hipLaunchKernelGGL(mk_fwd, dim3(grid), dim3(NWAVES * 64), LDS_BYTES, stream, a);
#else
    for (int p = 0; p < N_PHASES; ++p) { a.ph_lo = p; a.ph_hi = p + 1; hipLaunchKernelGGL(mk_fwd, dim3(grid), dim3(NWAVES * 64), LDS_BYTES, stream, a); }
#endif
    const hipError_t le = hipPeekAtLastError();
    if (le != hipSuccess) fprintf(stderr, "kernel_launch: launch failed: %s\n", hipGetErrorName(le));
}
```

```cpp
#define MK_N_LAUNCHES 1
#include <hip/hip_runtime.h>
#include <cstdio>
#include <cstdint>
namespace pg8 {
#define PG8_LAS __attribute__((address_space(3)))
typedef unsigned short bf16_t;
typedef short bf16x8 __attribute__((ext_vector_type(8)));
typedef float f32x4 __attribute__((ext_vector_type(4)));
typedef unsigned u32x4 __attribute__((ext_vector_type(4)));
constexpr int BM = 256, BK = 64, HALF = 128, HTB = HALF * BK * 2  , STAGE_BYTES = 8 * HTB, NXCD = 8, WGM = 8;

__host__ __device__ __forceinline__ int lds_byte(int r, int c) { const int st = (r >> 4) * 2 + (c >> 5), rr = r & 15, cc = c & 31, ob = rr * 64 + cc * 2; return st * 1024 + (ob ^ (((ob >> 9) & 1) << 5)); }
__host__ __device__ __forceinline__ void stage_rc(int b, int& R, int& C) { const int st = b / 1024, sb = b % 1024, swz = sb ^ (((sb >> 9) & 1) << 5); R = (st >> 1) * 16 + swz / 64; C = (st & 1) * 32 + (swz % 64) / 2; }
__host__ __device__ __forceinline__ int perm32(int rho) { const int n = rho >> 4, i = rho & 15; return 8 * (i >> 2) + 4 * n + (i & 3); }

struct Unit { int pm, pn; };
struct Gemm { const bf16_t* A; const bf16_t* Bt; int M, N, K; };

struct StaticOrder {
    int nM, nN, nwg, G, c;
    __host__ __device__ void init(int M, int N, int G_, int c_) { nM = M / BM; nN = N / BM; nwg = nM * nN; G = G_; c = c_; }
    __host__ __device__ bool next(int i, Unit& u) const {
        const long L = (long)i * G + c; if (L >= nwg) return false;
        int wgid = (int)L; { const int q = nwg / NXCD, r = nwg % NXCD, xcd = wgid % NXCD, off = wgid / NXCD; wgid = (xcd < r ? xcd * (q + 1) : r * (q + 1) + (xcd - r) * q) + off; }
        const int nig = WGM * nN, gid = wgid / nig, fm = gid * WGM, gsz = (nM - fm) < WGM ? (nM - fm) : WGM;
        u.pm = fm + ((wgid % nig) % gsz); u.pn = (wgid % nig) / gsz; return true;
    }
    __device__ __forceinline__ void a_ready(const Unit&) const {}
    __device__ __forceinline__ void done(const Unit&) const {}
};

__device__ __forceinline__ unsigned cvt_pk_bf16(float lo, float hi) { unsigned r; asm volatile("v_cvt_pk_bf16_f32 %0, %1, %2" : "=v"(r) : "v"(lo), "v"(hi)); return r; }
typedef float f32x2 __attribute__((ext_vector_type(2)));
template <class Epi, class Sched, bool ALIGN_EPI = false, bool SP2 = false>
__device__ __forceinline__ void gemm_phase(PG8_LAS unsigned char* lds, const Gemm g, const Sched& S, const Epi& E) {
    const int tid = threadIdx.x, wid = __builtin_amdgcn_readfirstlane(tid >> 6), lane = tid & 63, wr = wid >> 2, wc = wid & 3, fr = lane & 15, fq = lane >> 4;
    const int K = g.K, nt = K / BK;
    unsigned voffA[2], voffB[2];
#pragma unroll
    for (int i = 0; i < 2; ++i) { int R, C; stage_rc(tid * 16 + i * 8192, R, C); const int Rb = Epi::PERM ? ((R & ~31) + perm32(R & 31)) : R;
        voffA[i] = (unsigned)(R * K + C) * 2u; voffB[i] = (unsigned)(Rb * K + C) * 2u; }
    const size_t kstep = (size_t)(BK * 2);
    const size_t hstep = (size_t)HALF * K * 2;
    const size_t tstep = 2 * hstep;
    const unsigned ldsw = (unsigned)wid * 1024u;
    const int aoff = lds_byte(wr * 64 + fr, fq * 8), boff = lds_byte(wc * 32 + fr, fq * 8);
#define PG8_SA(b, h) (((b) * 2 + (h)) * HTB)
#define PG8_SB(b, h) ((4 + (b) * 2 + (h)) * HTB)
#define PG8_STAGE(bufoff, gbase, voff) do { _Pragma("unroll") for (int _i = 0; _i < 2; ++_i) \
        __builtin_amdgcn_global_load_lds((const unsigned*)((const char*)(gbase) + (voff)[_i]), (PG8_LAS unsigned*)(lds + (bufoff) + ldsw + _i * 8192), 16, 0, 0); } while (0)
#define PG8_LDA(dst, b, h) do { _Pragma("unroll") for (int m = 0; m < 4; ++m) _Pragma("unroll") for (int k = 0; k < 2; ++k) dst[m][k] = *(const PG8_LAS bf16x8*)(lds + PG8_SA(b, h) + aoff + m * 2048 + k * 1024); } while (0)
#define PG8_LDB(dst, b, h) do { _Pragma("unroll") for (int n = 0; n < 2; ++n) _Pragma("unroll") for (int k = 0; k < 2; ++k) dst[n][k] = *(const PG8_LAS bf16x8*)(lds + PG8_SB(b, h) + boff + n * 2048 + k * 1024); } while (0)
#define PG8_MMA(ai, bj, At, Bt) do { __builtin_amdgcn_s_setprio(1); _Pragma("unroll") for (int m = 0; m < 4; ++m) _Pragma("unroll") for (int n = 0; n < 2; ++n) _Pragma("unroll") for (int k = 0; k < 2; ++k) \
        acc[ai][bj][m][n] = __builtin_amdgcn_mfma_f32_16x16x32_bf16(Bt[n][k], At[m][k], acc[ai][bj][m][n], 0, 0, 0); __builtin_amdgcn_s_setprio(0); } while (0)
#define PG8_WAIT_V(n) asm volatile("s_waitcnt vmcnt(" #n ")" ::: "memory")
#define PG8_WAIT_L(n) asm volatile("s_waitcnt lgkmcnt(" #n ")" ::: "memory")
#define PG8_BAR __builtin_amdgcn_s_barrier()
#define PG8_SCHED __builtin_amdgcn_sched_barrier(0)
    Unit cur, nxt; int ui = 0;
    if (!S.next(0, cur)) return;
    f32x4 acc[2][2][4][2];
#pragma unroll
    for (int a = 0; a < 2; ++a)
#pragma unroll
        for (int b = 0; b < 2; ++b)
#pragma unroll
            for (int m = 0; m < 4; ++m)
#pragma unroll
                for (int n = 0; n < 2; ++n) acc[a][b][m][n] = (f32x4){0.f, 0.f, 0.f, 0.f};
    bf16x8 At[4][2], B0[2][2], B1[2][2];
    const char* cA = (const char*)g.A + (size_t)cur.pm * tstep; const char* cB = (const char*)g.Bt + (size_t)cur.pn * tstep;
    S.a_ready(cur);
    if constexpr (SP2) {
        PG8_STAGE(PG8_SB(0, 0), cB, voffB); PG8_STAGE(PG8_SB(0, 1), cB + hstep, voffB); PG8_STAGE(PG8_SA(0, 0), cA, voffA); PG8_STAGE(PG8_SA(0, 1), cA + hstep, voffA);
        if (wr == 1) PG8_BAR;
        PG8_WAIT_V(2); PG8_BAR;
        PG8_STAGE(PG8_SB(1, 0), cB + kstep, voffB); PG8_STAGE(PG8_SA(1, 0), cA + kstep, voffA); PG8_STAGE(PG8_SB(1, 1), cB + hstep + kstep, voffB);
        PG8_WAIT_V(6); PG8_BAR;
    } else {
        PG8_STAGE(PG8_SB(0, 0), cB, voffB); PG8_STAGE(PG8_SA(0, 0), cA, voffA); PG8_STAGE(PG8_SB(0, 1), cB + hstep, voffB); PG8_STAGE(PG8_SA(0, 1), cA + hstep, voffA);
        if (wr == 1) PG8_BAR;
        PG8_WAIT_V(4); PG8_BAR;
        PG8_STAGE(PG8_SB(1, 0), cB + kstep, voffB); PG8_STAGE(PG8_SA(1, 0), cA + kstep, voffA); PG8_STAGE(PG8_SB(1, 1), cB + hstep + kstep, voffB);
        PG8_WAIT_V(6); PG8_BAR;
    }
    for (;;) {
        const bool has_next = S.next(ui + 1, nxt);
        const char* nA = has_next ? (const char*)g.A + (size_t)nxt.pm * tstep : cA; const char* nB = has_next ? (const char*)g.Bt + (size_t)nxt.pn * tstep : cB;
        for (int t = 0; t < nt; t += 2) {
            const bool last = (t == nt - 2);
            const char* a1 = cA + (size_t)(t + 1) * kstep;
            const char* a2 = last ? nA : cA + (size_t)(t + 2) * kstep; const char* b2 = last ? nB : cB + (size_t)(t + 2) * kstep;
            const char* a3 = a2 + kstep; const char* b3 = b2 + kstep;
            if (last && has_next) S.a_ready(nxt);
            if constexpr (SP2) {
            PG8_LDB(B0, 0, 0); PG8_LDB(B1, 0, 1); PG8_SCHED; PG8_LDA(At, 0, 0); PG8_STAGE(PG8_SA(1, 1), a1 + hstep, voffA);
            PG8_WAIT_V(8); PG8_WAIT_L(0); PG8_BAR; PG8_MMA(0, 0, At, B0); PG8_MMA(0, 1, At, B1); PG8_BAR; PG8_SCHED;
            PG8_LDA(At, 0, 1); PG8_STAGE(PG8_SB(0, 0), b2, voffB); PG8_STAGE(PG8_SB(0, 1), b2 + hstep, voffB); PG8_STAGE(PG8_SA(0, 0), a2, voffA);
            PG8_WAIT_V(8); PG8_WAIT_L(0); PG8_BAR; PG8_MMA(1, 0, At, B0); PG8_MMA(1, 1, At, B1); PG8_BAR; PG8_SCHED;
            PG8_LDB(B0, 1, 0); PG8_LDB(B1, 1, 1); PG8_SCHED; PG8_LDA(At, 1, 0); PG8_STAGE(PG8_SA(0, 1), a2 + hstep, voffA);
            PG8_WAIT_V(8); PG8_WAIT_L(0); PG8_BAR; PG8_MMA(0, 0, At, B0); PG8_MMA(0, 1, At, B1); PG8_BAR; PG8_SCHED;
            PG8_LDA(At, 1, 1); PG8_STAGE(PG8_SB(1, 0), b3, voffB); PG8_STAGE(PG8_SB(1, 1), b3 + hstep, voffB); PG8_STAGE(PG8_SA(1, 0), a3, voffA);
            PG8_WAIT_V(8); PG8_WAIT_L(0); PG8_BAR; PG8_MMA(1, 0, At, B0); PG8_MMA(1, 1, At, B1); PG8_BAR; PG8_SCHED;
            } else {
            PG8_LDB(B0, 0, 0); PG8_SCHED; PG8_LDA(At, 0, 0); PG8_STAGE(PG8_SA(1, 1), a1 + hstep, voffA);
            PG8_WAIT_L(8); PG8_BAR; PG8_WAIT_L(0); PG8_MMA(0, 0, At, B0); PG8_BAR; PG8_SCHED;
            PG8_LDB(B1, 0, 1); PG8_STAGE(PG8_SB(0, 0), b2, voffB);
            PG8_BAR; PG8_WAIT_L(0); PG8_MMA(0, 1, At, B1); PG8_BAR;
            PG8_LDA(At, 0, 1); PG8_STAGE(PG8_SA(0, 0), a2, voffA);
            PG8_BAR; PG8_WAIT_L(0); PG8_MMA(1, 0, At, B0); PG8_BAR; PG8_SCHED;
            PG8_STAGE(PG8_SB(0, 1), b2 + hstep, voffB);
            PG8_WAIT_V(6); PG8_BAR; PG8_MMA(1, 1, At, B1); PG8_BAR;
            PG8_LDB(B0, 1, 0); PG8_SCHED; PG8_LDA(At, 1, 0); PG8_STAGE(PG8_SA(0, 1), a2 + hstep, voffA);
            PG8_WAIT_L(8); PG8_BAR; PG8_WAIT_L(0); PG8_MMA(0, 0, At, B0); PG8_BAR; PG8_SCHED;
            PG8_LDB(B1, 1, 1); PG8_STAGE(PG8_SB(1, 0), b3, voffB);
            PG8_BAR; PG8_WAIT_L(0); PG8_MMA(0, 1, At, B1); PG8_BAR;
            PG8_LDA(At, 1, 1); PG8_STAGE(PG8_SA(1, 0), a3, voffA);
            PG8_BAR; PG8_WAIT_L(0); PG8_MMA(1, 0, At, B0); PG8_BAR; PG8_SCHED;
            PG8_STAGE(PG8_SB(1, 1), b3 + hstep, voffB);
            PG8_WAIT_V(6); PG8_BAR; PG8_MMA(1, 1, At, B1); PG8_BAR;
            }
        }
        if constexpr (ALIGN_EPI) { if (wr == 0) PG8_BAR; }
        if constexpr (!Epi::AFTER_DRAIN) { E(acc, cur, wr, wc, fr, fq); S.done(cur); }
        if (!has_next) break;
#pragma unroll
        for (int a = 0; a < 2; ++a)
#pragma unroll
            for (int b = 0; b < 2; ++b)
#pragma unroll
                for (int m = 0; m < 4; ++m)
#pragma unroll
                    for (int n = 0; n < 2; ++n) acc[a][b][m][n] = (f32x4){0.f, 0.f, 0.f, 0.f};
        cur = nxt; cA = nA; cB = nB; ++ui;
        if constexpr (ALIGN_EPI) { if (wr == 1) PG8_BAR; }
    }
    PG8_WAIT_V(0);
    if constexpr (!ALIGN_EPI) { if (wr == 0) PG8_BAR; }
    PG8_BAR;
    if constexpr (Epi::AFTER_DRAIN) { E.fused(acc, cur, wr, wc, fr, fq, lds, wid, lane); S.done(cur); }
#undef PG8_SA
#undef PG8_SB
#undef PG8_STAGE
#undef PG8_LDA
#undef PG8_LDB
#undef PG8_MMA
#undef PG8_WAIT_V
#undef PG8_WAIT_L
#undef PG8_BAR
#undef PG8_SCHED
}
}
#define GAS __attribute__((address_space(1)))
#define LAS __attribute__((address_space(3)))
typedef unsigned short bf16;
typedef unsigned v4u __attribute__((ext_vector_type(4)));
typedef float f32x4 __attribute__((ext_vector_type(4)));
typedef short bf16x8 __attribute__((ext_vector_type(8)));
typedef GAS unsigned gu32;
typedef GAS unsigned long long gu64;
#define RLX_AGENT __ATOMIC_RELAXED, __HIP_MEMORY_SCOPE_AGENT
#define LDS_WAIT() asm volatile("s_waitcnt lgkmcnt(0)" ::: "memory")
#define VM_WAIT() asm volatile("s_waitcnt vmcnt(0)" ::: "memory")
__device__ __forceinline__ unsigned long long rt() { return __builtin_amdgcn_s_memrealtime(); }
__device__ __forceinline__ unsigned f2bf(float f) { unsigned u = __builtin_bit_cast(unsigned, f); return (u + 0x7fffu + ((u >> 16) & 1u)) >> 16; }
__device__ __forceinline__ unsigned pk2(float lo, float hi) { return f2bf(lo) | (f2bf(hi) << 16); }
#define XB_TMO      128
#define XB_XCNT(j)  (256  + 64 * (j))
#define XB_XSUB(j)  (1280 + 64 * (j))
#define XB_XGEN(j)  (2304 + 64 * (j))
#define XB_TOP      3328
#define XB_TOPGEN   3392
#define XCD_BAR_WORDS 3456
#define XB_SPIN_CAP (1u << 18)

__device__ __forceinline__ unsigned xb_ld(unsigned* p)              { return __hip_atomic_load(p, __ATOMIC_RELAXED, __HIP_MEMORY_SCOPE_AGENT); }
__device__ __forceinline__ unsigned xb_add(unsigned* p, unsigned v) { return __hip_atomic_fetch_add(p, v, __ATOMIC_RELAXED, __HIP_MEMORY_SCOPE_AGENT); }
__device__ __forceinline__ unsigned xb_xcc_id() { return (unsigned)__builtin_amdgcn_s_getreg((3 << 11) | 20) & 0xFu; }
#define XB_SPIN(cond, bar) do { unsigned _sp = 0; while (cond) { __builtin_amdgcn_s_sleep(1); \
    if ((++_sp & 255u) == 0u) { if (xb_ld(&(bar)[XB_TMO])) break; if (_sp > XB_SPIN_CAP) { atomicAdd(&(bar)[XB_TMO], 1u); break; } } } } while (0)

struct XcdBarrier {
    unsigned* bar; unsigned x;
    volatile LAS unsigned* st;
};

__device__ __forceinline__ XcdBarrier xcd_barrier_post(unsigned* bar, volatile LAS unsigned* st) {
    XcdBarrier b; b.bar = bar; b.x = xb_xcc_id(); b.st = st;
    if (threadIdx.x == 0) (void)xb_add(&bar[XB_XCNT(b.x)], 1u);
    return b;
}
__device__ __forceinline__ void xcd_barrier_complete(unsigned* bar, unsigned x, unsigned& nloc, unsigned& nx) {
    const unsigned G = gridDim.x * gridDim.y * gridDim.z;
    unsigned sum, cnt, mine, sp = 0u;
    for (;;) {
        sum = 0u; cnt = 0u; mine = 0u;
#pragma unroll
        for (unsigned j = 0; j < 16; ++j) { const unsigned c = xb_ld(&bar[XB_XCNT(j)]); sum += c; cnt += (c > 0u) ? 1u : 0u; mine = (j == x) ? c : mine; }
        if (sum == G) break;
        __builtin_amdgcn_s_sleep(1);
        if ((++sp & 255u) == 0u) { if (xb_ld(&bar[XB_TMO])) break; if (sp > XB_SPIN_CAP) { atomicAdd(&bar[XB_TMO], 1u); break; } }
    }
    nloc = mine > 0u ? mine : 1u; nx = cnt > 0u ? cnt : 1u;
}

__device__ __forceinline__ void xcd_barrier(const XcdBarrier& b) {
    asm volatile("s_waitcnt vmcnt(0)" ::: "memory");
    __syncthreads();
    if (threadIdx.x == 0) {
        unsigned* bar = b.bar;
        __builtin_amdgcn_s_waitcnt(0);
        unsigned nloc = b.st[0], nx = b.st[1];
        if (nloc == 0u) { xcd_barrier_complete(bar, b.x, nloc, nx); b.st[0] = nloc; b.st[1] = nx; }
        const unsigned old = xb_add(&bar[XB_XSUB(b.x)], 1u);
        const unsigned gen = old / nloc;
        if (old + 1u == (gen + 1u) * nloc) {
            __builtin_amdgcn_fence(__ATOMIC_RELEASE, "agent");
            asm volatile("s_waitcnt vmcnt(0)" ::: "memory");
            const unsigned og = xb_add(&bar[XB_TOP], 1u);
            const unsigned tg = og / nx;
            if (og + 1u == (tg + 1u) * nx) xb_add(&bar[XB_TOPGEN], 1u);
            else XB_SPIN(xb_ld(&bar[XB_TOPGEN]) == tg, bar);
            __builtin_amdgcn_fence(__ATOMIC_ACQUIRE, "agent");
            xb_add(&bar[XB_XGEN(b.x)], 1u);
            asm volatile("s_waitcnt vmcnt(0)" ::: "memory");
        } else {
            XB_SPIN(xb_ld(&bar[XB_XGEN(b.x)]) == gen, bar);
            __builtin_amdgcn_fence(__ATOMIC_ACQUIRE, "agent");
            asm volatile("s_waitcnt vmcnt(0)" ::: "memory");
        }
    }
    __syncthreads();
}

constexpr int NWAVES = 8;
constexpr int DM = 2048, RP = 8192, RS = 512, RT = RP + RS;
constexpr int PROJW = 9872, NPT = 39, PROJP = NPT * 256;
constexpr int LS = 2080, LSP = 2176;
constexpr int KROWS = RP + 16 * LSP;
constexpr float EPS = 1e-6f;
constexpr float LOG2E = 1.4426950408889634f;
constexpr float SC_DSA = 0.08838834764831845f * LOG2E;
constexpr float SC_MLA = 0.07216878364870323f * LOG2E;
constexpr float NEG_INF = -__builtin_inff();

enum { I_XP = 0, I_XS, I_CAK, I_CAV, I_CIK, I_CCKV, I_CKR, I_NG, I_WIN, I_WUQ, I_QNG, I_KVNG, I_WUK, I_WUV, I_WOA, I_WOB, I_WOUT, I_FG };

constexpr size_t O_Y = 0, O_PK = 17825792, O_PV = 19922944, O_PIK = 22020096, O_PCKV = 22544384, O_PKR = 26738688,
                 O_SK = 27262976, O_SV = 27394048, O_SIK = 27525120, O_SCKV = 27557888, O_SKR = 27820032, O_END = 27852800;

constexpr size_t MiB = 1u << 20;
constexpr size_t WS_CTL = 0, CTL_ZERO_BYTES = 65536;
constexpr size_t WS_ROPE = 1 * MiB;
constexpr size_t WS_WIN_T = 2 * MiB;
constexpr size_t WS_BIAS_P = WS_WIN_T;
constexpr size_t WS_WUQ_T = 41 * MiB;
constexpr size_t WS_WUKV_T = WS_WUQ_T + 1536 * 512 * 2;
constexpr size_t WS_WUK_B = WS_WUKV_T + 2 * MiB;
constexpr size_t WS_WUV_T = WS_WUK_B + 1 * MiB;
constexpr size_t WS_WOA_T = WS_WUV_T + 1 * MiB;
constexpr size_t WS_WOB_T = WS_WOA_T + 4 * MiB;
constexpr size_t WS_WOUT_T = WS_WOB_T + 4 * MiB;
constexpr size_t WS_AQ = WS_WOUT_T + 8 * MiB;
constexpr size_t WS_IQ = WS_AQ + 17 * MiB;
constexpr size_t WS_AGATE = WS_IQ + 17 * MiB;
constexpr size_t WS_BGATE = WS_AGATE + 17 * MiB;
constexpr size_t WS_G = WS_BGATE + 17 * MiB;
constexpr size_t WS_CQ = WS_G + 68 * MiB;
constexpr size_t WS_CKV = WS_CQ + (size_t)RT * 512 * 2;
constexpr size_t WS_AKC = WS_CKV + (size_t)RT * 512 * 2;
constexpr size_t WS_AVC = WS_AKC + (size_t)KROWS * 256 * 2;
constexpr size_t WS_IKC = WS_AVC + (size_t)KROWS * 256 * 2;
constexpr size_t WS_KRP = WS_IKC + (size_t)KROWS * 64 * 2;
constexpr size_t WS_KCAT = WS_KRP + (size_t)RT * 64 * 2;
constexpr size_t WS_IW = WS_KCAT + (size_t)16 * LSP * 576 * 2;
constexpr size_t WS_SSQQ = WS_IW + (size_t)RT * 16 * 4;
constexpr size_t WS_SSQKV = WS_SSQQ + (size_t)RT * 8 * 4;
constexpr size_t WS_SSQH = WS_SSQKV + (size_t)RT * 8 * 4;
constexpr size_t WS_BIAS_S = WS_SSQH + (size_t)RT * 32 * 4;
constexpr size_t WS_END = WS_BIAS_S + (size_t)RS * LSP * 4;
static_assert(WS_END <= 344000000ull, "ws budget");
static_assert(WS_WIN_T + (size_t)PROJP * DM * 2 <= WS_WUQ_T, "Win_t");
constexpr size_t TRI_B = 4096ull * 559;
static_assert(4 * TRI_B * 4 <= 39 * MiB, "bias_p fits the Win_t region");
constexpr size_t DO_XN = 0, DO_QN = 0, DO_QR = 17 * MiB, DO_KN = DO_QR + (size_t)RT * 512 * 2, DO_V = DO_KN + 16 * MiB;
static_assert(DO_V + 16 * MiB <= (size_t)RT * DM * 4, "y-region overlay");

constexpr int CW_TMO = 0, CW_Q3 = 64, CW_Q4 = 128, CW_Q4A = 192, CW_BAR = 4096;
static_assert((CW_BAR + XCD_BAR_WORDS) * 4 <= (int)CTL_ZERO_BYTES, "ctl");

constexpr int RING_OFF = 0, RING_BYTES = 131072;
constexpr int LDS_BYTES = 163840;
constexpr int LDSCTL_OFF = LDS_BYTES - 512, MISC_OFF = LDSCTL_OFF + 320;

constexpr int RT_COSA = 0, RT_COSI = 16, RT_COSR = 24, RT_SINA = 56, RT_SINI = 72, RT_SINR = 80, RT_W = 112;
__constant__ double INVF[56] = {
  1.0, 0.44036660267178046, 0.19392274474868576, 0.08539710028576561, 0.03760603093086393, 0.016560440080994446, 0.007292664737217109, 0.003211445994752591,
  0.001414213562373095, 0.000622772421914596, 0.0002742481756762073, 0.00012076973741146504, 5.318295896944988e-05, 2.341999896140934e-05, 1.031338537721246e-05, 4.5416704806078695e-06,
  1.0, 0.19392274474868576, 0.03760603093086393, 0.007292664737217109, 0.001414213562373095, 0.0002742481756762073, 5.318295896944988e-05, 1.031338537721246e-05,
  1.0, 0.6636012376960885, 0.44036660267178046, 0.2922278225730151, 0.19392274474868576, 0.12868737343265052, 0.08539710028576561, 0.05666962144529105,
  0.03760603093086393, 0.024955408670558694, 0.016560440080994446, 0.010989528534539826, 0.007292664737217109, 0.004839421345719893, 0.003211445994752591, 0.0021311195369119653,
  0.001414213562373095, 0.0009384738703573802, 0.000622772421914596, 0.0004132725499855165, 0.0002742481756762073, 0.00018199142881462546, 0.00012076973741146504, 8.01429472224798e-05,
  5.318295896944988e-05, 3.529227739646723e-05, 2.341999896140934e-05, 1.5541540297632344e-05, 1.031338537721246e-05, 6.8439753011549275e-06, 4.5416704806078695e-06, 3.013858152139171e-06 };

typedef float f32x16 __attribute__((ext_vector_type(16)));
typedef short s16x4 __attribute__((ext_vector_type(4)));
typedef unsigned u32x2 __attribute__((ext_vector_type(2)));

struct Frame {
    LAS unsigned char* lds;
    volatile LAS unsigned* MISC;
    gu32* ctl;
    int tid, lane, wave, vcu, G;
    const float* in[18];
    float* out;
    unsigned char* ws;
};
__device__ __forceinline__ float wave_sum(float v) {
#pragma unroll
    for (int o = 1; o < 64; o <<= 1) v += __shfl_xor(v, o);
    return v;
}
typedef float f32x2_t __attribute__((ext_vector_type(2))); typedef __bf16 bf16x2_t __attribute__((ext_vector_type(2)));
__device__ __forceinline__ unsigned cvtpk(float lo, float hi) { const f32x2_t v = {lo, hi}; const bf16x2_t b = __builtin_convertvector(v, bf16x2_t); return __builtin_bit_cast(unsigned, b); }
__device__ __forceinline__ float bf2f(unsigned short b) { return __builtin_bit_cast(float, (unsigned)b << 16); }
__device__ __forceinline__ int row_pos(int row) { return row < RP ? (row & 2047) : 2048 + ((row - RP) & 31); }
__device__ __forceinline__ int krow_of(int row) { return row < RP ? row : RP + ((row - RP) >> 5) * LSP + 2048 + ((row - RP) & 31); }
__device__ __forceinline__ float sigm_f(float x) { return __builtin_amdgcn_rcpf(1.f + __builtin_amdgcn_exp2f(-1.4426950408889634f * x)); }
__device__ __forceinline__ float silu_f(float x) { return x * sigm_f(x); }

__device__ __forceinline__ int map_win(int j) {
    if (j < 3584) return j;
    if (j < 3840) { const int c = j - 3584;
        if (c < 64) return 3584 + c;
        if (c < 80) return 3648 + (c - 64);
        if (c < 128) return -1;
        if (c < 192) { const int cp = c - 128, grp = cp >> 5, w = cp & 31, n = w >> 4, i = (w & 15) + 16 * grp; return 4688 + i + 32 * n; }
        return -1; }
    if (j < 4352) return 3664 + (j - 3840);
    if (j < 4864) return 4176 + (j - 4352);
    if (j < 5888) return 4752 + (j - 4864);
    return 5776 + (j - 5888);
}
__device__ __forceinline__ int map_wuq(int j) {
    if (j < 1024) return (j >> 7) * 192 + (j & 127);
    const int jp = j - 1024, h = jp >> 6, cp = jp & 63, grp = cp >> 5, w = cp & 31, n = w >> 4, i = (w & 15) + 16 * grp;
    return h * 192 + 128 + i + 32 * n;
}
template <int MODE>
__device__ __forceinline__ void p0_transpose_item(const float* W, int K, int Nsrc, bf16* WT, int row_off, int nblk, const float* kscale, LAS float* scr, int item, int lane) {
    const int kb = item / nblk, nb = item % nblk, k0 = 64 * kb, n0 = 32 * nb;
    const int jn = n0 + (lane & 31);
    const int src = MODE == 0 ? map_win(jn) : (MODE == 1 ? map_wuq(jn) : jn);
    float tv[32];
#pragma unroll
    for (int i = 0; i < 32; ++i) { const int kk = 2 * i + (lane >> 5); tv[i] = src >= 0 ? W[(size_t)(k0 + kk) * Nsrc + src] : 0.f; }
#pragma unroll
    for (int i = 0; i < 32; ++i) { const int kk = 2 * i + (lane >> 5); float v = tv[i]; if (kscale) v *= kscale[k0 + kk]; scr[kk * 33 + (lane & 31)] = v; }
    LDS_WAIT(); asm volatile("" ::: "memory");
    const int c = lane & 7;
#pragma unroll
    for (int j = 0; j < 4; ++j) { const int n = (lane >> 3) + 8 * j; const LAS float* s = scr + (8 * c) * 33 + n;
        v4u o; o.x = pk2(s[0 * 33], s[1 * 33]); o.y = pk2(s[2 * 33], s[3 * 33]); o.z = pk2(s[4 * 33], s[5 * 33]); o.w = pk2(s[6 * 33], s[7 * 33]);
        *(GAS v4u*)(WT + (size_t)(row_off + n0 + n) * K + k0 + 8 * c) = o; }
    LDS_WAIT(); asm volatile("" ::: "memory");
}
__device__ __forceinline__ v4u cvt8(const float* p) {
    const f32x4 a = *(const GAS f32x4*)p, b = *(const GAS f32x4*)(p + 4);
    v4u o; o.x = cvtpk(a.x, a.y); o.y = cvtpk(a.z, a.w); o.z = cvtpk(b.x, b.y); o.w = cvtpk(b.z, b.w); return o;
}
__device__ __forceinline__ void p0_prologue(Frame& F) {
    LAS float* scr = (LAS float*)(F.lds + RING_OFF + F.wave * 16384);
    const int gw = F.vcu * NWAVES + F.wave, NGW = F.G * NWAVES;
    bf16* win_t = (bf16*)(F.ws + WS_WIN_T); bf16* wuq_t = (bf16*)(F.ws + WS_WUQ_T); bf16* wukv_t = (bf16*)(F.ws + WS_WUKV_T);
    bf16* wuv_t = (bf16*)(F.ws + WS_WUV_T); bf16* woa_t = (bf16*)(F.ws + WS_WOA_T); bf16* wob_t = (bf16*)(F.ws + WS_WOB_T); bf16* wout_t = (bf16*)(F.ws + WS_WOUT_T);
    constexpr int I_IN = 32 * (PROJP / 32), I_UQ = 8 * 48, I_UK = 8 * 32, I_UV = 8 * 32, I_UVT = 8 * 32, I_OA = 16 * 64, I_OB = 16 * 64, I_OUT = 32 * 64;
    constexpr int NITEMS = I_IN + I_UQ + I_UK + I_UV + I_UVT + I_OA + I_OB + I_OUT;
    for (int it = gw; it < NITEMS; it += NGW) {
        int r = it;
        if (r < I_IN) { p0_transpose_item<0>(F.in[I_WIN], DM, PROJW, win_t, 0, PROJP / 32, nullptr, scr, r, F.lane); continue; } r -= I_IN;
        if (r < I_UQ) { p0_transpose_item<1>(F.in[I_WUQ], 512, 1536, wuq_t, 0, 48, F.in[I_QNG], scr, r, F.lane); continue; } r -= I_UQ;
        if (r < I_UK) { p0_transpose_item<2>(F.in[I_WUK], 512, 1024, wukv_t, 0, 32, F.in[I_KVNG], scr, r, F.lane); continue; } r -= I_UK;
        if (r < I_UV) { p0_transpose_item<2>(F.in[I_WUV], 512, 1024, wukv_t, 1024, 32, F.in[I_KVNG], scr, r, F.lane); continue; } r -= I_UV;
        if (r < I_UVT) { p0_transpose_item<2>(F.in[I_WUV], 512, 1024, wuv_t, 0, 32, nullptr, scr, r, F.lane); continue; } r -= I_UVT;
        if (r < I_OA) { p0_transpose_item<2>(F.in[I_WOA], 1024, 2048, woa_t, 0, 64, nullptr, scr, r, F.lane); continue; } r -= I_OA;
        if (r < I_OB) { p0_transpose_item<2>(F.in[I_WOB], 1024, 2048, wob_t, 0, 64, nullptr, scr, r, F.lane); continue; } r -= I_OB;
        p0_transpose_item<2>(F.in[I_WOUT], 2048, 2048, wout_t, 0, 64, nullptr, scr, r, F.lane);
    }
    {   bf16* XN = (bf16*)((unsigned char*)F.out + DO_XN); const float* g = F.in[I_NG];
        for (int m = gw; m < RT; m += NGW) {
            const float* xrow = m < RP ? F.in[I_XP] + (size_t)m * DM : F.in[I_XS] + (size_t)(m - RP) * DM;
            const GAS f32x4* xr = (const GAS f32x4*)xrow + F.lane; const GAS f32x4* gr = (const GAS f32x4*)g + F.lane;
            f32x4 v[8]; float s = 0.f;
#pragma unroll
            for (int j = 0; j < 8; ++j) { v[j] = xr[64 * j]; s += (v[j].x * v[j].x + v[j].y * v[j].y) + (v[j].z * v[j].z + v[j].w * v[j].w); }
            const float rs = 1.0f / sqrtf(wave_sum(s) * (1.f / DM) + EPS);
            GAS u32x2* o8 = (GAS u32x2*)(XN + (size_t)m * DM) + F.lane;
#pragma unroll
            for (int j = 0; j < 8; ++j) { const f32x4 gg = gr[64 * j]; u32x2 w; w.x = cvtpk(v[j].x * rs * gg.x, v[j].y * rs * gg.y); w.y = cvtpk(v[j].z * rs * gg.z, v[j].w * rs * gg.w); o8[64 * j] = w; }
        }
    }
    {   const long gt = (long)F.vcu * (NWAVES * 64) + F.tid, NGT = (long)F.G * NWAVES * 64;
        bf16* akc = (bf16*)(F.ws + WS_AKC); bf16* avc = (bf16*)(F.ws + WS_AVC); bf16* ikc = (bf16*)(F.ws + WS_IKC); bf16* kcat = (bf16*)(F.ws + WS_KCAT); bf16* wuk_b = (bf16*)(F.ws + WS_WUK_B);
        for (long i = gt; i < 512 * 1024 / 8; i += NGT) *(GAS v4u*)(wuk_b + i * 8) = cvt8(F.in[I_WUK] + i * 8);
#define CVT_LOOP(TOTAL, SRC, DSTEXPR) do { for (long i0 = gt; i0 < (TOTAL); i0 += 4 * NGT) { v4u t_[4]; \
            _Pragma("unroll") for (int q_ = 0; q_ < 4; ++q_) { const long i = i0 + q_ * NGT; if (i < (TOTAL)) t_[q_] = cvt8((SRC) + i * 8); } \
            _Pragma("unroll") for (int q_ = 0; q_ < 4; ++q_) { const long i = i0 + q_ * NGT; if (i < (TOTAL)) *(GAS v4u*)(DSTEXPR) = t_[q_]; } } } while (0)
        CVT_LOOP(16L * 2048 * 32, F.in[I_CAK], akc + ((size_t)(RP + (i >> 16) * LSP + ((i & 65535) >> 5)) * 256 + (i & 31) * 8));
        CVT_LOOP(16L * 2048 * 32, F.in[I_CAV], avc + ((size_t)(RP + (i >> 16) * LSP + ((i & 65535) >> 5)) * 256 + (i & 31) * 8));
        CVT_LOOP(16L * 2048 * 8, F.in[I_CIK], ikc + ((size_t)(RP + (i >> 14) * LSP + ((i & 16383) >> 3)) * 64 + (i & 7) * 8));
        CVT_LOOP(16L * 2048 * 64, F.in[I_CCKV], kcat + ((size_t)((i >> 17) * LSP + ((i & 131071) >> 6)) * 576 + (i & 63) * 8));
        CVT_LOOP(16L * 2048 * 8, F.in[I_CKR], kcat + ((size_t)((i >> 14) * LSP + ((i & 16383) >> 3)) * 576 + 512 + (i & 7) * 8));
#undef CVT_LOOP
        const v4u z = {0u, 0u, 0u, 0u};
        for (long i = gt; i < 16L * (LSP - LS) * 32; i += NGT) { const long b = i / ((LSP - LS) * 32), rem = i % ((LSP - LS) * 32); const long s = LS + rem / 32, c8 = rem % 32;
            const size_t d = ((size_t)(RP + b * LSP + s) * 256 + c8 * 8); *(GAS v4u*)(akc + d) = z; *(GAS v4u*)(avc + d) = z; }
        for (long i = gt; i < 16L * (LSP - LS) * 72; i += NGT) { const long b = i / ((LSP - LS) * 72), rem = i % ((LSP - LS) * 72); const long s = LS + rem / 72, c8 = rem % 72;
            *(GAS v4u*)(kcat + ((size_t)(b * LSP + s) * 576 + c8 * 8)) = z; }
        float* tab = (float*)(F.ws + WS_ROPE);
        for (long i = gt; i < 2080L * 56; i += NGT) { const int pos = (int)(i / 56), f = (int)(i % 56);
            const double a = (double)pos * INVF[f]; const double n = __builtin_rint(a * 0.15915494309189535);
            double r = __builtin_fma(-n, 6.283185307179586, a); r = __builtin_fma(-n, 2.4492935982947064e-16, r);
            const float rf = (float)r; tab[(size_t)pos * RT_W + f] = cosf(rf); tab[(size_t)pos * RT_W + 56 + f] = sinf(rf); }
    }
}

using pg8::Unit;
#define EPI_ROWS(ai, m) (u.pm * 256 + (ai) * 128 + wr * 64 + (m) * 16 + fr)
__device__ __forceinline__ void st_bf4(bf16* p, const f32x4 v) { u32x2 w; w.x = cvtpk(v.x, v.y); w.y = cvtpk(v.z, v.w); *(GAS u32x2*)p = w; }
__device__ __forceinline__ void st_f4(float* p, const f32x4 v) { *(GAS f32x4*)p = v; }

struct EpiInProj {
    static constexpr bool PERM = false, AFTER_DRAIN = false;
    float* out; unsigned char* ws;
    __device__ __forceinline__ void operator()(f32x4 (&acc)[2][2][4][2], const Unit& u, int wr, int wc, int fr_, int fq_) const {
        int fr = fr_, fq = fq_; asm volatile("" : "+v"(fr), "+v"(fq));
        const int pn = u.pn; const bool samp = u.pm >= 32;
        const float* tab = (const float*)(ws + WS_ROPE);
        const int cl = wc * 32 + 4 * fq;
#ifndef EPI_DIS
#define EPI_DIS 0
#endif
        if ((EPI_DIS & 1) && pn < 5) {} else if ((EPI_DIS & 2) && pn == 5) {} else if ((EPI_DIS & 4) && ((pn >= 6 && pn < 10) || (pn >= 19 && pn < 23))) {} else if ((EPI_DIS & 8) && pn >= 10 && pn < 14) {} else if ((EPI_DIS & 16) && pn == 14) {} else if ((EPI_DIS & 32) && pn >= 15 && pn < 19) {} else if ((EPI_DIS & 64) && pn >= 23) {} else
        if (pn < 5) {
            bf16* AQ = (bf16*)(ws + WS_AQ); bf16* AKC = (bf16*)(ws + WS_AKC);
            float* OK = samp ? out + O_SK : out + O_PK;
#pragma unroll
            for (int ai = 0; ai < 2; ++ai)
#pragma unroll
                for (int m = 0; m < 4; ++m) { int row = EPI_ROWS(ai, m); asm volatile("" : "+v"(row) :: "memory");
                    if (wc == 0) { const float* tp = tab + (size_t)row_pos(row) * RT_W + 4 * fq; const f32x4 cs = *(const GAS f32x4*)(tp + RT_COSA), sn = *(const GAS f32x4*)(tp + RT_SINA);
#pragma unroll
                        for (int bj = 0; bj < 2; ++bj) { const f32x4 x1 = acc[ai][bj][m][0], x2 = acc[ai][bj][m][1]; acc[ai][bj][m][0] = x1 * cs - x2 * sn; acc[ai][bj][m][1] = x2 * cs + x1 * sn; } }
#pragma unroll
                    for (int bj = 0; bj < 2; ++bj)
#pragma unroll
                        for (int n = 0; n < 2; ++n) { const int c = bj * 128 + n * 16 + cl;
                            if (pn < 4) st_bf4(AQ + (size_t)row * 1024 + pn * 256 + c, acc[ai][bj][m][n]);
                            else { st_bf4(AKC + (size_t)krow_of(row) * 256 + c, acc[ai][bj][m][n]); st_f4(OK + (size_t)(samp ? row - RP : row) * 256 + c, acc[ai][bj][m][n]); } } }
        } else if (pn == 5) {
            bf16* AVC = (bf16*)(ws + WS_AVC); float* OV = samp ? out + O_SV : out + O_PV;
#pragma unroll
            for (int ai = 0; ai < 2; ++ai)
#pragma unroll
                for (int m = 0; m < 4; ++m) { int row = EPI_ROWS(ai, m); asm volatile("" : "+v"(row) :: "memory");
#pragma unroll
                    for (int bj = 0; bj < 2; ++bj)
#pragma unroll
                        for (int n = 0; n < 2; ++n) { const int c = bj * 128 + n * 16 + cl;
                            st_bf4(AVC + (size_t)krow_of(row) * 256 + c, acc[ai][bj][m][n]); st_f4(OV + (size_t)(samp ? row - RP : row) * 256 + c, acc[ai][bj][m][n]); } }
        } else if (pn < 10 || (pn >= 19 && pn < 23)) {
            bf16* Gt = pn < 10 ? (bf16*)(ws + WS_AGATE) + (pn - 6) * 256 : (bf16*)(ws + WS_BGATE) + (pn - 19) * 256;
#pragma unroll
            for (int ai = 0; ai < 2; ++ai)
#pragma unroll
                for (int m = 0; m < 4; ++m) { int row = EPI_ROWS(ai, m); asm volatile("" : "+v"(row) :: "memory");
#pragma unroll
                    for (int bj = 0; bj < 2; ++bj)
#pragma unroll
                        for (int n = 0; n < 2; ++n) { f32x4 v = acc[ai][bj][m][n]; v.x = silu_f(v.x); v.y = silu_f(v.y); v.z = silu_f(v.z); v.w = silu_f(v.w);
                            st_bf4(Gt + (size_t)row * 1024 + bj * 128 + n * 16 + cl, v); } }
        } else if (pn < 14) {
            bf16* IQ = (bf16*)(ws + WS_IQ) + (pn - 10) * 256;
#pragma unroll
            for (int ai = 0; ai < 2; ++ai)
#pragma unroll
                for (int m = 0; m < 4; ++m) { int row = EPI_ROWS(ai, m); asm volatile("" : "+v"(row) :: "memory");
                    if ((wc & 1) == 0) { const float* tp = tab + (size_t)row_pos(row) * RT_W + 4 * (fq & 1); const f32x4 cs = *(const GAS f32x4*)(tp + RT_COSI), sn = *(const GAS f32x4*)(tp + RT_SINI);
#pragma unroll
                        for (int bj = 0; bj < 2; ++bj) { const f32x4 v = acc[ai][bj][m][0]; f32x4 o;
                            o.x = __shfl_xor(v.x, 32); o.y = __shfl_xor(v.y, 32); o.z = __shfl_xor(v.z, 32); o.w = __shfl_xor(v.w, 32);
                            acc[ai][bj][m][0] = fq < 2 ? v * cs - o * sn : v * cs + o * sn; } }
#pragma unroll
                    for (int bj = 0; bj < 2; ++bj)
#pragma unroll
                        for (int n = 0; n < 2; ++n) st_bf4(IQ + (size_t)row * 1024 + bj * 128 + n * 16 + cl, acc[ai][bj][m][n]); }
        } else if (pn == 14) {
            bf16* IKC = (bf16*)(ws + WS_IKC); bf16* KRP = (bf16*)(ws + WS_KRP); bf16* KCAT = (bf16*)(ws + WS_KCAT); float* IW = (float*)(ws + WS_IW);
            float* OIK = samp ? out + O_SIK : out + O_PIK; float* OKR = samp ? out + O_SKR : out + O_PKR;
#pragma unroll
            for (int ai = 0; ai < 2; ++ai)
#pragma unroll
                for (int m = 0; m < 4; ++m) { int row = EPI_ROWS(ai, m); asm volatile("" : "+v"(row) :: "memory"); const int orow = samp ? row - RP : row; const int pos = row_pos(row);
                    if (wc < 2) {
                        if (wc == 0) { const float* tp = tab + (size_t)pos * RT_W + 4 * (fq & 1); const f32x4 cs = *(const GAS f32x4*)(tp + RT_COSI), sn = *(const GAS f32x4*)(tp + RT_SINI);
                            const f32x4 v = acc[ai][0][m][0]; f32x4 o; o.x = __shfl_xor(v.x, 32); o.y = __shfl_xor(v.y, 32); o.z = __shfl_xor(v.z, 32); o.w = __shfl_xor(v.w, 32);
                            acc[ai][0][m][0] = fq < 2 ? v * cs - o * sn : v * cs + o * sn; }
#pragma unroll
                        for (int n = 0; n < 2; ++n) { const int c = n * 16 + cl; st_f4(OIK + (size_t)orow * 64 + c, acc[ai][0][m][n]); st_bf4(IKC + (size_t)krow_of(row) * 64 + c, acc[ai][0][m][n]); }
                        { const int i0 = 16 * wc + 4 * fq; const float* tp = tab + (size_t)pos * RT_W + i0; const f32x4 cs = *(const GAS f32x4*)(tp + RT_COSR), sn = *(const GAS f32x4*)(tp + RT_SINR);
                            const f32x4 x1 = acc[ai][1][m][0], x2 = acc[ai][1][m][1]; const f32x4 o1 = x1 * cs - x2 * sn, o2 = x2 * cs + x1 * sn;
                            st_f4(OKR + (size_t)orow * 64 + i0, o1); st_f4(OKR + (size_t)orow * 64 + 32 + i0, o2);
                            if (samp) { bf16* kc = KCAT + (size_t)(krow_of(row) - RP) * 576 + 512; st_bf4(kc + i0, o1); st_bf4(kc + 32 + i0, o2); }
                            else { st_bf4(KRP + (size_t)row * 64 + i0, o1); st_bf4(KRP + (size_t)row * 64 + 32 + i0, o2); } }
                    } else if (wc == 2) {
                        st_f4(IW + (size_t)row * 16 + 4 * fq, acc[ai][0][m][0] * 0.03125f);
                    } }
        } else if (pn < 19) {
            const bool isq = pn < 17; const int t = isq ? pn - 15 : pn - 17;
            bf16* C = (bf16*)(ws + (isq ? WS_CQ : WS_CKV)) + t * 256; float* SS = (float*)(ws + (isq ? WS_SSQQ : WS_SSQKV));
            float* OC = (samp ? out + O_SCKV : out + O_PCKV) + t * 256;
#pragma unroll
            for (int ai = 0; ai < 2; ++ai)
#pragma unroll
                for (int m = 0; m < 4; ++m) { int row = EPI_ROWS(ai, m); asm volatile("" : "+v"(row) :: "memory"); float s = 0.f;
#pragma unroll
                    for (int bj = 0; bj < 2; ++bj)
#pragma unroll
                        for (int n = 0; n < 2; ++n) { const f32x4 v = acc[ai][bj][m][n]; s += (v.x * v.x + v.y * v.y) + (v.z * v.z + v.w * v.w);
                            st_bf4(C + (size_t)row * 512 + bj * 128 + n * 16 + cl, v);
                            if (!isq) st_f4(OC + (size_t)(samp ? row - RP : row) * 512 + bj * 128 + n * 16 + cl, v); }
                    s += __shfl_xor(s, 16); s += __shfl_xor(s, 32);
                    if (fq == 0) SS[(size_t)row * 8 + t * 4 + wc] = s; }
        } else {
            bf16* Gt = (bf16*)(ws + WS_G) + (pn - 23) * 256;
#pragma unroll
            for (int ai = 0; ai < 2; ++ai)
#pragma unroll
                for (int m = 0; m < 4; ++m) { int row = EPI_ROWS(ai, m); asm volatile("" : "+v"(row) :: "memory");
#pragma unroll
                    for (int bj = 0; bj < 2; ++bj)
#pragma unroll
                        for (int n = 0; n < 2; ++n) { f32x4 v = acc[ai][bj][m][n]; v.x = sigm_f(v.x); v.y = sigm_f(v.y); v.z = sigm_f(v.z); v.w = sigm_f(v.w);
                            st_bf4(Gt + (size_t)row * 4096 + bj * 128 + n * 16 + cl, v); } }
        }
    }
};

struct OrderP2 {
    int G, c;
    __device__ __forceinline__ bool next(int i, Unit& u) const {
        const int L = i * G + c;
        if (L < 204) { u.pm = L / 6; u.pn = L % 6; return true; }
        const int L2 = L - 204; if (L2 >= 256) return false;
        u.pm = 34 + (L2 >> 3); u.pn = 6 + (L2 & 7); return true;
    }
    __device__ __forceinline__ void a_ready(const Unit&) const {}
    __device__ __forceinline__ void done(const Unit&) const {}
};
struct EpiP2 {
    static constexpr bool PERM = false, AFTER_DRAIN = false;
    float* out; unsigned char* ws;
    __device__ __forceinline__ void operator()(f32x4 (&acc)[2][2][4][2], const Unit& u0, int wr, int wc, int fr_, int fq_) const {
        int fr = fr_, fq = fq_; asm volatile("" : "+v"(fr), "+v"(fq));
        const bool isq = u0.pn < 6; Unit u; u.pm = isq ? u0.pm : u0.pm - 34; u.pn = isq ? u0.pn : u0.pn - 6;
        const float* SS = (const float*)(ws + (isq ? WS_SSQQ : WS_SSQKV)); const float* tab = (const float*)(ws + WS_ROPE);
        bf16* QN = (bf16*)((unsigned char*)out + DO_QN); bf16* QR = (bf16*)((unsigned char*)out + DO_QR); bf16* KN = (bf16*)((unsigned char*)out + DO_KN); bf16* V = (bf16*)((unsigned char*)out + DO_V);
        const int cl = wc * 32 + 4 * fq;
#pragma unroll
        for (int ai = 0; ai < 2; ++ai)
#pragma unroll
            for (int m = 0; m < 4; ++m) { int row = EPI_ROWS(ai, m); asm volatile("" : "+v"(row) :: "memory");
                const f32x4 s0 = *(const GAS f32x4*)(SS + (size_t)row * 8), s1 = *(const GAS f32x4*)(SS + (size_t)row * 8 + 4);
                const float rs = 1.0f / sqrtf(((s0.x + s0.y) + (s0.z + s0.w) + (s1.x + s1.y) + (s1.z + s1.w)) * (1.f / 512.f) + EPS);
                if (isq && u.pn >= 4) {
                    const int i0 = 16 * (wc & 1) + 4 * fq; const float* tp = tab + (size_t)row_pos(row) * RT_W + i0; const f32x4 cs = *(const GAS f32x4*)(tp + RT_COSR), sn = *(const GAS f32x4*)(tp + RT_SINR);
#pragma unroll
                    for (int bj = 0; bj < 2; ++bj) { const int h = (u.pn - 4) * 4 + 2 * bj + (wc >> 1); const f32x4 x1 = acc[ai][bj][m][0] * rs, x2 = acc[ai][bj][m][1] * rs;
                        st_bf4(QR + (size_t)row * 512 + h * 64 + i0, x1 * cs - x2 * sn); st_bf4(QR + (size_t)row * 512 + h * 64 + 32 + i0, x2 * cs + x1 * sn); }
                } else {
                    bf16* D = isq ? QN + u.pn * 256 : (u.pn < 4 ? KN + u.pn * 256 : V + (u.pn - 4) * 256);
#pragma unroll
                    for (int bj = 0; bj < 2; ++bj)
#pragma unroll
                        for (int n = 0; n < 2; ++n) st_bf4(D + (size_t)row * 1024 + bj * 128 + n * 16 + cl, acc[ai][bj][m][n] * rs);
                } }
    }
};

struct OrderP5 {
    int G, c;
    __device__ __forceinline__ bool next(int i, Unit& u) const {
        const int t = (i >> 1) * G + c, half = i & 1; if (t >= 256) return false;
        u.pm = (t >> 3) + 34 * half; u.pn = (t & 7) + 8 * half; return true;
    }
    __device__ __forceinline__ void a_ready(const Unit&) const {}
    __device__ __forceinline__ void done(const Unit&) const {}
};
struct EpiP5 {
    static constexpr bool PERM = false, AFTER_DRAIN = false;
    float* out; unsigned char* ws;
    __device__ __forceinline__ void operator()(f32x4 (&acc)[2][2][4][2], const Unit& u0, int wr, int wc, int fr_, int fq_) const {
        int fr = fr_, fq = fq_; asm volatile("" : "+v"(fr), "+v"(fq));
        const int half = u0.pn >= 8; Unit u; u.pm = u0.pm - 34 * half; u.pn = u0.pn - 8 * half;
        const bf16* Gt = (const bf16*)(ws + WS_G) + half * 2048 + u.pn * 256; float* M1 = out + u.pn * 256; bf16* M = (bf16*)(ws + WS_AGATE) + u.pn * 256;
        const int cl = wc * 32 + 4 * fq;
#pragma unroll
        for (int ai = 0; ai < 2; ++ai)
#pragma unroll
            for (int m = 0; m < 4; ++m) { int row = EPI_ROWS(ai, m); asm volatile("" : "+v"(row) :: "memory");
#pragma unroll
                for (int bj = 0; bj < 2; ++bj)
#pragma unroll
                    for (int n = 0; n < 2; ++n) { const int c = bj * 128 + n * 16 + cl;
                        const u32x2 gw = *(const GAS u32x2*)(Gt + (size_t)row * 4096 + c);
                        f32x4 g; g.x = __builtin_bit_cast(float, gw.x << 16); g.y = __builtin_bit_cast(float, gw.x & 0xffff0000u); g.z = __builtin_bit_cast(float, gw.y << 16); g.w = __builtin_bit_cast(float, gw.y & 0xffff0000u);
                        f32x4 v = acc[ai][bj][m][n] * g;
                        if (half == 0) st_f4(M1 + (size_t)row * DM + c, v);
                        else { v += *(const GAS f32x4*)(M1 + (size_t)row * DM + c); st_bf4(M + (size_t)row * DM + c, v); } } }
    }
};

struct EpiP6 {
    static constexpr bool PERM = false, AFTER_DRAIN = false;
    float* out; unsigned char* ws; const float* xp; const float* xs;
    __device__ __forceinline__ void operator()(f32x4 (&acc)[2][2][4][2], const Unit& u, int wr, int wc, int fr_, int fq_) const {
        int fr = fr_, fq = fq_; asm volatile("" : "+v"(fr), "+v"(fq));
        const int cl = wc * 32 + 4 * fq;
#pragma unroll
        for (int ai = 0; ai < 2; ++ai)
#pragma unroll
            for (int m = 0; m < 4; ++m) { int row = EPI_ROWS(ai, m); asm volatile("" : "+v"(row) :: "memory"); const float* xr = (row < RP ? xp + (size_t)row * DM : xs + (size_t)(row - RP) * DM) + u.pn * 256;
#pragma unroll
                for (int bj = 0; bj < 2; ++bj)
#pragma unroll
                    for (int n = 0; n < 2; ++n) { const int c = bj * 128 + n * 16 + cl; const f32x4 v = acc[ai][bj][m][n] + *(const GAS f32x4*)(xr + c);
                        st_f4(out + (size_t)row * DM + u.pn * 256 + c, v); } }
    }
};

namespace sg {
__device__ __forceinline__ void gemm128(LAS unsigned char* lds, const bf16* A, int lda, const bf16* Bt, int ldb, int K, f32x4 (&acc)[4][2]) {
    const int tid = threadIdx.x, wid = __builtin_amdgcn_readfirstlane(tid >> 6), lane = tid & 63, wr = wid >> 2, wc = wid & 3, fr = lane & 15, fq = lane >> 4;
    unsigned voffA[2], voffB[2];
#pragma unroll
    for (int i = 0; i < 2; ++i) { int R, C; pg8::stage_rc(tid * 16 + i * 8192, R, C); voffA[i] = (unsigned)(R * lda + C) * 2u; voffB[i] = (unsigned)(R * ldb + C) * 2u; }
    const int aoff = pg8::lds_byte(wr * 64 + fr, fq * 8), boff = pg8::lds_byte(wc * 32 + fr, fq * 8);
    const unsigned ldsw = (unsigned)wid * 1024u; const int nt = K / 64;
#define SG_STAGE(buf, kt) do { _Pragma("unroll") for (int i_ = 0; i_ < 2; ++i_) { \
        __builtin_amdgcn_global_load_lds((const unsigned*)((const char*)A + voffA[i_] + (size_t)(kt) * 128), (LAS unsigned*)(lds + (buf) * 32768 + ldsw + i_ * 8192), 16, 0, 0); \
        __builtin_amdgcn_global_load_lds((const unsigned*)((const char*)Bt + voffB[i_] + (size_t)(kt) * 128), (LAS unsigned*)(lds + (buf) * 32768 + 16384 + ldsw + i_ * 8192), 16, 0, 0); } } while (0)
    SG_STAGE(0, 0);
    for (int t = 0; t < nt; ++t) {
        asm volatile("s_waitcnt vmcnt(0)" ::: "memory"); __builtin_amdgcn_s_barrier(); asm volatile("" ::: "memory");
        const int b = t & 1;
        if (t + 1 < nt) SG_STAGE(b ^ 1, t + 1);
        bf16x8 Af[4][2], Bf[2][2];
#pragma unroll
        for (int m = 0; m < 4; ++m)
#pragma unroll
            for (int k = 0; k < 2; ++k) Af[m][k] = *(const LAS bf16x8*)(lds + b * 32768 + aoff + m * 2048 + k * 1024);
#pragma unroll
        for (int n = 0; n < 2; ++n)
#pragma unroll
            for (int k = 0; k < 2; ++k) Bf[n][k] = *(const LAS bf16x8*)(lds + b * 32768 + 16384 + boff + n * 2048 + k * 1024);
#pragma unroll
        for (int m = 0; m < 4; ++m)
#pragma unroll
            for (int n = 0; n < 2; ++n)
#pragma unroll
                for (int k = 0; k < 2; ++k) acc[m][n] = __builtin_amdgcn_mfma_f32_16x16x32_bf16(Bf[n][k], Af[m][k], acc[m][n], 0, 0, 0);
    }
    asm volatile("s_waitcnt lgkmcnt(0)" ::: "memory"); __builtin_amdgcn_s_barrier(); asm volatile("" ::: "memory");
#undef SG_STAGE
}
__device__ __forceinline__ void p5_sample(Frame& F, int rh, int ch) {
    const int tid = threadIdx.x, wid = __builtin_amdgcn_readfirstlane(tid >> 6), lane = tid & 63, wr = wid >> 2, wc = wid & 3, fr = lane & 15, fq = lane >> 4;
    const int row0 = RP + 128 * rh, col0 = 128 * ch;
    f32x4 qa[4][2], qb[4][2];
#pragma unroll
    for (int m = 0; m < 4; ++m)
#pragma unroll
        for (int n = 0; n < 2; ++n) { qa[m][n] = (f32x4){0.f, 0.f, 0.f, 0.f}; qb[m][n] = (f32x4){0.f, 0.f, 0.f, 0.f}; }
    gemm128(F.lds + RING_OFF, (const bf16*)(F.ws + WS_AQ) + (size_t)row0 * 1024, 1024, (const bf16*)(F.ws + WS_WOA_T) + (size_t)col0 * 1024, 1024, 1024, qa);
    gemm128(F.lds + RING_OFF, (const bf16*)(F.ws + WS_IQ) + (size_t)row0 * 1024, 1024, (const bf16*)(F.ws + WS_WOB_T) + (size_t)col0 * 1024, 1024, 1024, qb);
    const bf16* Gt = (const bf16*)(F.ws + WS_G); bf16* M = (bf16*)(F.ws + WS_AGATE);
#pragma unroll
    for (int m = 0; m < 4; ++m) { const int row = row0 + wr * 64 + m * 16 + fr;
#pragma unroll
        for (int n = 0; n < 2; ++n) { const int c = col0 + wc * 32 + n * 16 + 4 * fq;
            const u32x2 ga = *(const GAS u32x2*)(Gt + (size_t)row * 4096 + c), gb = *(const GAS u32x2*)(Gt + (size_t)row * 4096 + 2048 + c);
            f32x4 a, b; a.x = __builtin_bit_cast(float, ga.x << 16); a.y = __builtin_bit_cast(float, ga.x & 0xffff0000u); a.z = __builtin_bit_cast(float, ga.y << 16); a.w = __builtin_bit_cast(float, ga.y & 0xffff0000u);
            b.x = __builtin_bit_cast(float, gb.x << 16); b.y = __builtin_bit_cast(float, gb.x & 0xffff0000u); b.z = __builtin_bit_cast(float, gb.y << 16); b.w = __builtin_bit_cast(float, gb.y & 0xffff0000u);
            st_bf4(M + (size_t)row * DM + c, qa[m][n] * a + qb[m][n] * b); } }
}
__device__ __forceinline__ void p6_sample(Frame& F, int rh, int ch) {
    const int tid = threadIdx.x, wid = __builtin_amdgcn_readfirstlane(tid >> 6), lane = tid & 63, wr = wid >> 2, wc = wid & 3, fr = lane & 15, fq = lane >> 4;
    const int row0 = RP + 128 * rh, col0 = 128 * ch;
    f32x4 q[4][2];
#pragma unroll
    for (int m = 0; m < 4; ++m)
#pragma unroll
        for (int n = 0; n < 2; ++n) q[m][n] = (f32x4){0.f, 0.f, 0.f, 0.f};
    gemm128(F.lds + RING_OFF, (const bf16*)(F.ws + WS_AGATE) + (size_t)row0 * DM, DM, (const bf16*)(F.ws + WS_WOUT_T) + (size_t)col0 * DM, DM, DM, q);
#pragma unroll
    for (int m = 0; m < 4; ++m) { const int row = row0 + wr * 64 + m * 16 + fr;
#pragma unroll
        for (int n = 0; n < 2; ++n) { const int c = col0 + wc * 32 + n * 16 + 4 * fq;
            st_f4(F.out + (size_t)row * DM + c, q[m][n] + *(const GAS f32x4*)(F.in[I_XS] + (size_t)(row - RP) * DM + c)); } }
}
}

__device__ __forceinline__ int crow(int r, int hi) { return (r & 3) + 8 * (r >> 2) + 4 * hi; }
__device__ __forceinline__ size_t tri_off(int b, int c) { return (size_t)b * TRI_B + 4096ull * (size_t)(c * (c + 3) / 2); }
__device__ __forceinline__ int tri_stride(int c) { return c >= 31 ? 2048 : (c + 2) * 64; }
constexpr int IQ_LDS_STRIDE = 2064;

__device__ __forceinline__ void idx_unit(Frame& F, int set, int b, int c, int sub, int part = 3) {
    const int lane = F.lane, wid = F.wave, r32 = lane & 31, hi = lane >> 5;
    const int row0 = set == 0 ? b * 2048 + c * 64 + sub * 32 : RP + b * 32;
    const int krow0 = set == 0 ? b * 2048 : RP + b * LSP;
    const int nkeys = set == 0 ? (c + 1) * 64 : LS;
    const int stride = set == 0 ? tri_stride(c) : LSP;
    float* brow0 = set == 0 ? (float*)(F.ws + WS_BIAS_P) + tri_off(b, c) + (size_t)(sub * 32) * stride : (float*)(F.ws + WS_BIAS_S) + (size_t)(b * 32) * LSP;
    const bf16* IQ = (const bf16*)(F.ws + WS_IQ); const bf16* IKC = (const bf16*)(F.ws + WS_IKC); const float* IW = (const float*)(F.ws + WS_IW);
    LAS unsigned char* L = F.lds + RING_OFF;
#pragma unroll
    for (int i = 0; i < 8; ++i) { const int id = F.tid + 512 * i, r = id >> 7, ch = id & 127;
        const v4u v = *(const GAS v4u*)(IQ + (size_t)(row0 + r) * 1024 + ch * 8); *(LAS v4u*)(L + r * IQ_LDS_STRIDE + ch * 16) = v; }
    LAS float* WL = (LAS float*)(L + 32 * IQ_LDS_STRIDE);
    { const int q = F.tid >> 4, h = F.tid & 15; WL[q * 17 + h] = IW[(size_t)(row0 + q) * 16 + h]; }
    __syncthreads();
    const int nkt = (part & 1) ? nkeys >> 5 : 0;
    for (int kt = wid; kt < nkt; kt += NWAVES) {
        const int k0 = kt * 32;
        bf16x8 kf[4];
#pragma unroll
        for (int ks = 0; ks < 4; ++ks) kf[ks] = *(const GAS bf16x8*)(IKC + (size_t)(krow0 + k0 + r32) * 64 + ks * 16 + hi * 8);
        f32x16 sc = {};
#pragma unroll 2
        for (int h = 0; h < 16; ++h) { f32x16 d = {}; const float w = WL[r32 * 17 + h];
#pragma unroll
            for (int ks = 0; ks < 4; ++ks) { const bf16x8 bq = *(const LAS bf16x8*)(L + r32 * IQ_LDS_STRIDE + h * 128 + (ks * 16 + hi * 8) * 2); d = __builtin_amdgcn_mfma_f32_32x32x16_bf16(kf[ks], bq, d, 0, 0, 0); }
#pragma unroll
            for (int r = 0; r < 16; ++r) sc[r] += w * fmaxf(d[r], 0.f); }
        float* br = brow0 + (size_t)r32 * stride + k0 + 4 * hi;
#pragma unroll
        for (int a = 0; a < 4; ++a) { f32x4 v = {sc[4 * a], sc[4 * a + 1], sc[4 * a + 2], sc[4 * a + 3]}; *(GAS f32x4*)(br + 8 * a) = v; }
    }
    VM_WAIT(); __syncthreads();
    const int K = 256; const int nch = (nkeys + 63) >> 6;
    LAS unsigned* H = (LAS unsigned*)(L + 32 * IQ_LDS_STRIDE + 4096) + wid * 256;
    for (int qi = 0; qi < ((part & 2) ? 4 : 0); ++qi) {
        float* br = brow0 + (size_t)(wid * 4 + qi) * stride;
        unsigned uk[34];
#pragma unroll
        for (int i = 0; i < 34; ++i) { const int idx = lane + 64 * i; unsigned u = 0u;
            if (i < nch && idx < nkeys) { const unsigned bits = __builtin_bit_cast(unsigned, br[idx]); u = bits ^ ((unsigned)((int)bits >> 31) | 0x80000000u); }
            uk[i] = u; }
        unsigned prefix = 0u;
        if (nkeys > K) {
            unsigned mask = 0u; int need = K;
#pragma unroll 1
            for (int sh = 24; sh >= 0; sh -= 8) {
                *(LAS v4u*)(H + 4 * lane) = (v4u){0u, 0u, 0u, 0u};
#pragma unroll
                for (int i = 0; i < 34; ++i) if (i < nch) { const unsigned u = uk[i]; if (u != 0u && (u & mask) == prefix) __hip_atomic_fetch_add(H + ((u >> sh) & 255u), 1u, __ATOMIC_RELAXED, __HIP_MEMORY_SCOPE_WORKGROUP); }
                asm volatile("s_waitcnt lgkmcnt(0)" ::: "memory");
                const v4u h = *(LAS v4u*)(H + 4 * lane);
                const int t = (int)(h.x + h.y + h.z + h.w); int sfx = t;
#pragma unroll
                for (int o = 1; o < 64; o <<= 1) { const int v = __shfl_down(sfx, o); if (lane + o < 64) sfx += v; }
                const int excl = sfx - t;
                const bool mine = excl < need && need <= sfx;
                const int c3 = excl + (int)h.w, c2 = c3 + (int)h.z, c1 = c2 + (int)h.y;
                int d, nn;
                if (need <= c3) { d = 4 * lane + 3; nn = need - excl; } else if (need <= c2) { d = 4 * lane + 2; nn = need - c3; } else if (need <= c1) { d = 4 * lane + 1; nn = need - c2; } else { d = 4 * lane; nn = need - c1; }
                const unsigned long long bm = __ballot(mine); const int src = bm ? (int)__builtin_ctzll(bm) : 0;
                d = __shfl(d, src); need = __shfl(nn, src);
                prefix |= (unsigned)d << sh; mask |= 255u << sh;
            }
        }
#pragma unroll
        for (int i = 0; i < 34; ++i) { const int idx = lane + 64 * i; if (idx < stride) br[idx] = (idx < nkeys && uk[i] >= prefix && uk[i] != 0u) ? 0.f : NEG_INF; }
    }
    VM_WAIT(); __syncthreads();
}

__device__ __forceinline__ void ckv_norm(Frame& F) {
    const int gw = F.vcu * NWAVES + F.wave, NGW = F.G * NWAVES; const float* SS = (const float*)(F.ws + WS_SSQKV); const float* g = F.in[I_KVNG]; bf16* KCAT = (bf16*)(F.ws + WS_KCAT);
    for (int m = gw; m < RT; m += NGW) {
        float* p = m < RP ? F.out + O_PCKV + (size_t)m * 512 : F.out + O_SCKV + (size_t)(m - RP) * 512;
        const f32x4 s0 = *(const GAS f32x4*)(SS + (size_t)m * 8), s1 = *(const GAS f32x4*)(SS + (size_t)m * 8 + 4);
        const float rs = 1.0f / sqrtf(((s0.x + s0.y) + (s0.z + s0.w) + (s1.x + s1.y) + (s1.z + s1.w)) * (1.f / 512.f) + EPS);
#pragma unroll
        for (int j = 0; j < 2; ++j) { const int c = (F.lane + 64 * j) * 4; const f32x4 gg = *(const GAS f32x4*)(g + c); f32x4 v = *(const GAS f32x4*)(p + c); v = v * rs * gg; *(GAS f32x4*)(p + c) = v;
            if (m >= RP) st_bf4(KCAT + (size_t)(krow_of(m) - RP) * 576 + c, v); }
    }
}

namespace att {
constexpr int SHM_V = 16384, SHM_K = 16384, SHM_KR = 8192, KVBLK = 64;
constexpr int OFF_V = 0, OFF_K = 2 * SHM_V, OFF_KR = OFF_K + 2 * SHM_K, OFF_WS = OFF_KR + 2 * SHM_KR, BYTES = OFF_WS + 8 * 64 * 4;
#define KSWZ(row, colB) ((row) * 256 + ((colB) ^ (((row) & 7) << 4)))
#define KRSWZ(row, colB) ((row) * 128 + ((colB) ^ (((row) & 7) << 4)))
#define SBAR() __builtin_amdgcn_sched_barrier(0)

__device__ __forceinline__ void partialSM(f32x16& p0, f32x16& p1, float& m_reg, float& mn, float& alpha, float C, float thr) {
    float pmax = p0[0];
#pragma unroll
    for (int r = 1; r < 16; ++r) pmax = fmaxf(pmax, p0[r]);
#pragma unroll
    for (int r = 0; r < 16; ++r) pmax = fmaxf(pmax, p1[r]);
    { auto rr = __builtin_amdgcn_permlane32_swap(__float_as_uint(pmax), __float_as_uint(pmax), false, false); pmax = fmaxf(__uint_as_float(rr[0]), __uint_as_float(rr[1])); }
    if (__builtin_expect(__all(pmax - m_reg <= thr), 1)) { mn = m_reg; alpha = 1.f; }
    else { mn = fmaxf(m_reg, pmax); alpha = __builtin_amdgcn_exp2f((m_reg - mn) * C); m_reg = mn; }
    const float mnC = -mn * C;
#pragma unroll
    for (int r = 0; r < 16; ++r) p0[r] = fmaf(p0[r], C, mnC);
#pragma unroll
    for (int r = 0; r < 16; ++r) p1[r] = fmaf(p1[r], C, mnC);
#pragma unroll
    for (int r = 0; r < 16; ++r) p0[r] = __builtin_amdgcn_exp2f(p0[r]);
}
__device__ __forceinline__ void finishSM(f32x16& p0, f32x16& p1, float alpha, float& l_reg, bf16x8& pa0, bf16x8& pa1, bf16x8& pa2, bf16x8& pa3) {
#pragma unroll
    for (int r = 0; r < 16; ++r) p1[r] = __builtin_amdgcn_exp2f(p1[r]);
    float ps = 0;
#pragma unroll
    for (int r = 0; r < 16; ++r) ps += p0[r];
#pragma unroll
    for (int r = 0; r < 16; ++r) ps += p1[r];
    { auto rr = __builtin_amdgcn_permlane32_swap(__float_as_uint(ps), __float_as_uint(ps), false, false); ps = __uint_as_float(rr[0]) + __uint_as_float(rr[1]); }
    l_reg = l_reg * alpha + ps;
#define PK4(P, BASE, OUT) do { unsigned a0 = cvtpk(P[BASE + 0], P[BASE + 1]), a1 = cvtpk(P[BASE + 2], P[BASE + 3]);   \
    unsigned b0 = cvtpk(P[BASE + 4], P[BASE + 5]), b1 = cvtpk(P[BASE + 6], P[BASE + 7]);                              \
    auto r0 = __builtin_amdgcn_permlane32_swap(a0, b0, false, false); auto r1 = __builtin_amdgcn_permlane32_swap(a1, b1, false, false); \
    v4u w = {r0[0], r1[0], r0[1], r1[1]}; OUT = __builtin_bit_cast(bf16x8, w); } while (0)
    PK4(p0, 0, pa0); PK4(p0, 8, pa1); PK4(p1, 0, pa2); PK4(p1, 8, pa3);
#undef PK4
}
template <bool ROPE>
__device__ __forceinline__ void qkt(f32x16& p0, f32x16& p1, const LAS char* Ks, const LAS char* KRs, const bf16x8* qr, const bf16* qrp, int r32, int hi) {
    bf16x8 qrr[4];
    if constexpr (ROPE) { asm volatile("" : "+v"(qrp));
#pragma unroll
        for (int d0 = 0; d0 < 4; ++d0) qrr[d0] = *(const GAS bf16x8*)(qrp + d0 * 16); }
#pragma unroll
    for (int d0 = 0; d0 < 8; ++d0) { const int cb = (d0 * 16 + hi * 8) * 2;
        const bf16x8 b0 = *(const LAS bf16x8*)(Ks + KSWZ(r32, cb)); const bf16x8 b1 = *(const LAS bf16x8*)(Ks + KSWZ(32 + r32, cb));
        p0 = __builtin_amdgcn_mfma_f32_32x32x16_bf16(b0, qr[d0], p0, 0, 0, 0); p1 = __builtin_amdgcn_mfma_f32_32x32x16_bf16(b1, qr[d0], p1, 0, 0, 0); }
    if constexpr (ROPE) {
#pragma unroll
        for (int d0 = 0; d0 < 4; ++d0) { const int cb = (d0 * 16 + hi * 8) * 2;
            const bf16x8 b0 = *(const LAS bf16x8*)(KRs + KRSWZ(r32, cb)); const bf16x8 b1 = *(const LAS bf16x8*)(KRs + KRSWZ(32 + r32, cb));
            p0 = __builtin_amdgcn_mfma_f32_32x32x16_bf16(b0, qrr[d0], p0, 0, 0, 0); p1 = __builtin_amdgcn_mfma_f32_32x32x16_bf16(b1, qrr[d0], p1, 0, 0, 0); }
    }
}
__device__ __forceinline__ int v_st(int k, int c) { const int kk = (k & ~0xC) | ((k & 4) << 1) | ((k & 8) >> 1); return ((kk >> 3) * 4 + (c >> 5)) * 512 + ((kk & 7) * 32 + (c & 31)) * 2; }
__device__ __forceinline__ int v_rd_base(int lane) { return ((lane & 3) << 3) | (((lane >> 2) & 3) << 6) | (((lane >> 4) & 1) << 5) | (((lane >> 5) & 1) << 8); }
constexpr int v_rd_off(int d0, int ks, int half) { return d0 * 512 + ks * 4096 + half * 2048; }
template <int OFF> __device__ __forceinline__ s16x4 tr_read(int vb) { s16x4 r; asm volatile("ds_read_b64_tr_b16 %0, %1 offset:%2" : "=&v"(r) : "v"(vb), "i"(OFF) : "memory"); return r; }
template <int D0> __device__ __forceinline__ void pv_one(f32x16& od, int vb, bf16x8 pa0, bf16x8 pa1, bf16x8 pa2, bf16x8 pa3) {
    const s16x4 l0 = tr_read<v_rd_off(D0, 0, 0)>(vb), h0 = tr_read<v_rd_off(D0, 0, 1)>(vb), l1 = tr_read<v_rd_off(D0, 1, 0)>(vb), h1 = tr_read<v_rd_off(D0, 1, 1)>(vb);
    const s16x4 l2 = tr_read<v_rd_off(D0, 2, 0)>(vb), h2 = tr_read<v_rd_off(D0, 2, 1)>(vb), l3 = tr_read<v_rd_off(D0, 3, 0)>(vb), h3 = tr_read<v_rd_off(D0, 3, 1)>(vb);
    asm volatile("s_waitcnt lgkmcnt(0)" ::: "memory"); SBAR();
#define PKV(L, H) (bf16x8){L[0], L[1], L[2], L[3], H[0], H[1], H[2], H[3]}
    od = __builtin_amdgcn_mfma_f32_32x32x16_bf16(pa0, PKV(l0, h0), od, 0, 0, 0);
    od = __builtin_amdgcn_mfma_f32_32x32x16_bf16(pa1, PKV(l1, h1), od, 0, 0, 0);
    od = __builtin_amdgcn_mfma_f32_32x32x16_bf16(pa2, PKV(l2, h2), od, 0, 0, 0);
    od = __builtin_amdgcn_mfma_f32_32x32x16_bf16(pa3, PKV(l3, h3), od, 0, 0, 0);
#undef PKV
}
__device__ __forceinline__ void pv_d0(f32x16* o, int vb, bf16x8 pa0, bf16x8 pa1, bf16x8 pa2, bf16x8 pa3) {
    pv_one<0>(o[0], vb, pa0, pa1, pa2, pa3); pv_one<1>(o[1], vb, pa0, pa1, pa2, pa3); pv_one<2>(o[2], vb, pa0, pa1, pa2, pa3); pv_one<3>(o[3], vb, pa0, pa1, pa2, pa3);
}

template <bool ROPE, bool BIAS>
__device__ __forceinline__ void attn_body(const bf16* Qrow, const bf16* QRrow, const float* biasrow, int jmax, const bf16* __restrict__ Kh, const bf16* __restrict__ Vh, int ldk,
                                          const bf16* __restrict__ KRh, int NT, float C, bf16* Ow, const bf16* Gw, bool active, LAS char* lds) {
    const int tid = threadIdx.x, lane = tid & 63, r32 = lane & 31, hi = lane >> 5; const int wid = __builtin_amdgcn_readfirstlane(tid >> 6);
    LAS char* V_lds = lds + OFF_V; LAS char* K_lds = lds + OFF_K; LAS char* KR_lds = lds + OFF_KR;
    LAS float* wsf = (LAS float*)(lds + OFF_WS) + wid * 64; LAS float* li_l = wsf; LAS float* al_l = wsf + 32;
    const float thr = 8.f * LOG2E / C;
    float m_reg = -1e30f, l_reg = 0; f32x16 o[4] = {}; bf16x8 qr[8];
#pragma unroll
    for (int d0 = 0; d0 < 8; ++d0) qr[d0] = *(const GAS bf16x8*)(Qrow + d0 * 16 + hi * 8);
    const bf16* qrp0 = ROPE ? QRrow + hi * 8 : nullptr;
    const int sr = tid >> 4, sc = (tid & 15) * 8, vst0 = v_st(sr, sc), vst1 = v_st(32 + sr, sc);
    const int krr = tid >> 3, krc = (tid & 7) * 8;
    const int vb0 = (int)(uintptr_t)V_lds + v_rd_base(lane);
    const bf16* kp = Kh + (size_t)sr * ldk + sc; const bf16* vp = Vh + (size_t)sr * ldk + sc; const bf16* krp = ROPE ? KRh + (size_t)krr * 64 + krc : nullptr;
    const size_t tstep = (size_t)64 * ldk, hstep = (size_t)32 * ldk;
    struct { bf16x8 vs0, vs1, ks0, ks1, kr; } st;
#define SLOAD() do { st.vs0 = *(const GAS bf16x8*)vp; st.vs1 = *(const GAS bf16x8*)(vp + hstep); st.ks0 = *(const GAS bf16x8*)kp; st.ks1 = *(const GAS bf16x8*)(kp + hstep); \
    if constexpr (ROPE) { st.kr = *(const GAS bf16x8*)krp; krp += 64 * 64; } kp += tstep; vp += tstep; } while (0)
#define SWRITE(b) do { *(LAS bf16x8*)(V_lds + (b) * SHM_V + vst0) = st.vs0; *(LAS bf16x8*)(V_lds + (b) * SHM_V + vst1) = st.vs1; const int kc = sc * 2; \
    *(LAS bf16x8*)(K_lds + (b) * SHM_K + KSWZ(sr, kc)) = st.ks0; *(LAS bf16x8*)(K_lds + (b) * SHM_K + KSWZ(32 + sr, kc)) = st.ks1; \
    if constexpr (ROPE) *(LAS bf16x8*)(KR_lds + (b) * SHM_KR + KRSWZ(krr, krc * 2)) = st.kr; } while (0)
    SLOAD(); SWRITE(0); __syncthreads();
    for (int j = 0; j < NT; ++j) {
        const int buf = j & 1; const bool more = j + 1 < NT;
        if (more) SLOAD();
        f32x16 p0, p1;
        if constexpr (BIAS) { const float* bp = biasrow + j * 64 + 4 * hi;
#pragma unroll
            for (int a = 0; a < 4; ++a) { const f32x4 t0 = *(const GAS f32x4*)(bp + 8 * a), t1 = *(const GAS f32x4*)(bp + 32 + 8 * a);
                p0[4 * a] = t0.x; p0[4 * a + 1] = t0.y; p0[4 * a + 2] = t0.z; p0[4 * a + 3] = t0.w; p1[4 * a] = t1.x; p1[4 * a + 1] = t1.y; p1[4 * a + 2] = t1.z; p1[4 * a + 3] = t1.w; }
        } else { const float iv = j > jmax ? NEG_INF : 0.f;
#pragma unroll
            for (int r = 0; r < 16; ++r) { p0[r] = iv; p1[r] = iv; } }
        qkt<ROPE>(p0, p1, K_lds + buf * SHM_K, KR_lds + buf * SHM_KR, qr, qrp0, r32, hi);
        float mn, alpha; partialSM(p0, p1, m_reg, mn, alpha, C, thr);
        if (__any(alpha < 1.f)) { if (hi == 0) al_l[r32] = alpha; asm volatile("s_waitcnt lgkmcnt(0)" ::: "memory");
#pragma unroll
            for (int d = 0; d < 4; ++d)
#pragma unroll
                for (int r = 0; r < 16; ++r) o[d][r] *= al_l[crow(r, hi)]; }
        bf16x8 pa0, pa1, pa2, pa3; finishSM(p0, p1, alpha, l_reg, pa0, pa1, pa2, pa3); SBAR();
        pv_d0(o, vb0 + buf * SHM_V, pa0, pa1, pa2, pa3);
        if (more) SWRITE(buf ^ 1);
        __syncthreads();
    }
    if (hi == 0) li_l[r32] = l_reg; asm volatile("s_waitcnt lgkmcnt(0)" ::: "memory");
    if (active) {
#pragma unroll
        for (int r = 0; r < 16; ++r) { const int orow = crow(r, hi); const float rl = __builtin_amdgcn_rcpf(li_l[orow]);
#pragma unroll
            for (int d0 = 0; d0 < 4; ++d0) { const size_t off = (size_t)orow * 1024 + d0 * 32 + r32; const float g = bf2f(Gw[off]); Ow[off] = (bf16)f2bf(o[d0][r] * rl * g); } }
    }
    __syncthreads();
#undef SLOAD
#undef SWRITE
}
}

namespace smla {
constexpr int KSTR = 1168;
constexpr int OSTR = 1040;
typedef short v4i16_t __attribute__((ext_vector_type(4)));
__device__ __forceinline__ s16x4 vtr(const LAS char* p) { return __builtin_bit_cast(s16x4, __builtin_amdgcn_ds_read_tr16_b64_v4i16((LAS v4i16_t*)p)); }

__device__ __forceinline__ void unit(Frame& F, int b, int hp, bool dry = false) {
    const int tid = F.tid, lane = F.lane, wid = F.wave, l15 = lane & 15, G = lane >> 4;
    const int rg = wid & 3, kh = wid >> 2, head = 2 * hp + (rg >> 1), t0 = 16 * (rg & 1);
    const int row = RP + b * 32 + t0 + l15;
    const bf16* QN = (const bf16*)((unsigned char*)F.out + DO_QN); const bf16* QR = (const bf16*)((unsigned char*)F.out + DO_QR);
    const bf16* WUK = (const bf16*)(F.ws + WS_WUK_B); const bf16* WUVT = (const bf16*)(F.ws + WS_WUV_T); const bf16* KCAT = (const bf16*)(F.ws + WS_KCAT) + (size_t)b * LSP * 576;
    LAS char* L = (LAS char*)(F.lds + RING_OFF);
    LAS char* QL = L + 64 * KSTR;
    if (kh == 0) {
        bf16x8 qn[4];
#pragma unroll
        for (int kd = 0; kd < 4; ++kd) qn[kd] = *(const GAS bf16x8*)(QN + (size_t)row * 1024 + head * 128 + kd * 32 + G * 8);
        LAS char* qrow = QL + (16 * rg + l15) * KSTR + G * 16;
#pragma unroll 2
        for (int a = 0; a < 16; ++a) { f32x4 d0 = {0.f, 0.f, 0.f, 0.f}, d1 = {0.f, 0.f, 0.f, 0.f};
#pragma unroll
            for (int kd = 0; kd < 4; ++kd) {
                const bf16x8 w0 = *(const GAS bf16x8*)(WUK + (size_t)(32 * a + l15) * 1024 + head * 128 + kd * 32 + G * 8);
                const bf16x8 w1 = *(const GAS bf16x8*)(WUK + (size_t)(32 * a + 16 + l15) * 1024 + head * 128 + kd * 32 + G * 8);
                d0 = __builtin_amdgcn_mfma_f32_16x16x32_bf16(w0, qn[kd], d0, 0, 0, 0); d1 = __builtin_amdgcn_mfma_f32_16x16x32_bf16(w1, qn[kd], d1, 0, 0, 0); }
#if defined(SMLA_CHK) && SMLA_CHK == 1
            { const float t_ = (d0.x + d0.y) + (d0.z + d0.w) + (d1.x + d1.y) + (d1.z + d1.w); if (!(fabsf(t_) < 3e38f)) F.MISC[6] = 1u; }
#endif
            v4u w; w.x = cvtpk(d0.x, d0.y); w.y = cvtpk(d0.z, d0.w); w.z = cvtpk(d1.x, d1.y); w.w = cvtpk(d1.z, d1.w); *(LAS v4u*)(qrow + a * 64) = w; }
#pragma unroll
        for (int a = 16; a < 18; ++a) { const bf16* qp = QR + (size_t)row * 512 + head * 64 + (a - 16) * 32 + 4 * G;
            const u32x2 lo = *(const GAS u32x2*)qp, hi2 = *(const GAS u32x2*)(qp + 16); v4u w = {lo.x, lo.y, hi2.x, hi2.y}; *(LAS v4u*)(qrow + a * 64) = w;
#if defined(SMLA_CHK) && SMLA_CHK == 10
            if ((w.x & 0x7f80u) == 0x7f80u || (w.x & 0x7f800000u) == 0x7f800000u || (w.y & 0x7f80u) == 0x7f80u || (w.y & 0x7f800000u) == 0x7f800000u || (w.z & 0x7f80u) == 0x7f80u || (w.z & 0x7f800000u) == 0x7f800000u || (w.w & 0x7f80u) == 0x7f80u || (w.w & 0x7f800000u) == 0x7f800000u) F.MISC[6] = 1u;
#endif
            }
    }
    const LAS char* qbase = QL + (16 * rg + l15) * KSTR + G * 16;
#ifdef SMLA_CHK
    if (tid == 0) F.MISC[6] = 0u;
#endif
    f32x4 acc[32];
#pragma unroll
    for (int c = 0; c < 32; ++c) acc[c] = (f32x4){0.f, 0.f, 0.f, 0.f};
    float m_run = -1e30f, l_run = 0.f;
    const float C = SC_MLA;
    const LAS char* kbase = L + (kh * 32 + l15) * KSTR + 8 * G;
    const LAS char* vbase = L + (kh * 32 + 4 * G + (l15 >> 2)) * KSTR + (l15 & 3) * 8;
    v4u pf[9];
    const bf16* kg = KCAT + (size_t)(tid >> 3) * 576 + (tid & 7) * 8; LAS char* kl = L + (tid >> 3) * KSTR + (tid & 7) * 16;
#pragma unroll
    for (int j = 0; j < 9; ++j) pf[j] = *(const GAS v4u*)(kg + j * 64);
    for (int kt = 0; kt < 33; ++kt) {
#pragma unroll
        for (int j = 0; j < 9; ++j) *(LAS v4u*)(kl + j * 128) = pf[j];
        __syncthreads();
        if (kt + 1 < 33) { kg += 64 * 576;
#pragma unroll
            for (int j = 0; j < 9; ++j) pf[j] = *(const GAS v4u*)(kg + j * 64); }
        f32x4 s0 = {0.f, 0.f, 0.f, 0.f}, s1 = {0.f, 0.f, 0.f, 0.f};
#pragma unroll
        for (int a = 0; a < 18; ++a) {
            const u32x2 k00 = *(const LAS u32x2*)(kbase + a * 64), k01 = *(const LAS u32x2*)(kbase + a * 64 + 32);
            const u32x2 k10 = *(const LAS u32x2*)(kbase + 16 * KSTR + a * 64), k11 = *(const LAS u32x2*)(kbase + 16 * KSTR + a * 64 + 32);
            const v4u w0 = {k00.x, k00.y, k01.x, k01.y}, w1 = {k10.x, k10.y, k11.x, k11.y};
            const bf16x8 qfa = *(const LAS bf16x8*)(qbase + a * 64);
#if defined(SMLA_CHK) && SMLA_CHK == 9
            { const v4u w = __builtin_bit_cast(v4u, qfa); if ((w.x & 0x7f80u) == 0x7f80u || (w.x & 0x7f800000u) == 0x7f800000u || (w.y & 0x7f80u) == 0x7f80u || (w.y & 0x7f800000u) == 0x7f800000u || (w.z & 0x7f80u) == 0x7f80u || (w.z & 0x7f800000u) == 0x7f800000u || (w.w & 0x7f80u) == 0x7f80u || (w.w & 0x7f800000u) == 0x7f800000u) F.MISC[6] = 1u; }
#endif
            s0 = __builtin_amdgcn_mfma_f32_16x16x32_bf16(__builtin_bit_cast(bf16x8, w0), qfa, s0, 0, 0, 0);
            s1 = __builtin_amdgcn_mfma_f32_16x16x32_bf16(__builtin_bit_cast(bf16x8, w1), qfa, s1, 0, 0, 0); }
#if defined(SMLA_CHK) && SMLA_CHK == 2
        if (!(fabsf(s0.x) < 3e38f)) F.MISC[6] = 1u; if (!(fabsf(s0.y) < 3e38f)) F.MISC[6] = 1u; if (!(fabsf(s0.z) < 3e38f)) F.MISC[6] = 1u; if (!(fabsf(s0.w) < 3e38f)) F.MISC[6] = 1u; if (!(fabsf(s1.x) < 3e38f)) F.MISC[6] = 1u; if (!(fabsf(s1.y) < 3e38f)) F.MISC[6] = 1u; if (!(fabsf(s1.z) < 3e38f)) F.MISC[6] = 1u; if (!(fabsf(s1.w) < 3e38f)) F.MISC[6] = 1u;
#endif
        if (kt == 32) { if (kh == 1) { s0 = (f32x4){NEG_INF, NEG_INF, NEG_INF, NEG_INF}; s1 = s0; } }
        float tmax = fmaxf(fmaxf(fmaxf(s0.x, s0.y), fmaxf(s0.z, s0.w)), fmaxf(fmaxf(s1.x, s1.y), fmaxf(s1.z, s1.w)));
        tmax = fmaxf(tmax, __shfl_xor(tmax, 16)); tmax = fmaxf(tmax, __shfl_xor(tmax, 32));
        const float m_new = fmaxf(m_run, tmax); const float alpha = __builtin_amdgcn_exp2f((m_run - m_new) * C); const float mC = -m_new * C; m_run = m_new;
        f32x4 p0, p1;
        p0.x = __builtin_amdgcn_exp2f(fmaf(s0.x, C, mC)); p0.y = __builtin_amdgcn_exp2f(fmaf(s0.y, C, mC)); p0.z = __builtin_amdgcn_exp2f(fmaf(s0.z, C, mC)); p0.w = __builtin_amdgcn_exp2f(fmaf(s0.w, C, mC));
        p1.x = __builtin_amdgcn_exp2f(fmaf(s1.x, C, mC)); p1.y = __builtin_amdgcn_exp2f(fmaf(s1.y, C, mC)); p1.z = __builtin_amdgcn_exp2f(fmaf(s1.z, C, mC)); p1.w = __builtin_amdgcn_exp2f(fmaf(s1.w, C, mC));
        float ps = (p0.x + p0.y) + (p0.z + p0.w) + (p1.x + p1.y) + (p1.z + p1.w);
        ps += __shfl_xor(ps, 16); ps += __shfl_xor(ps, 32);
        l_run = l_run * alpha + ps;
#if defined(SMLA_CHK) && SMLA_CHK == 3
        if (!(fabsf(l_run) < 3e38f)) F.MISC[6] = 1u; if (!(fabsf(ps) < 3e38f)) F.MISC[6] = 1u; if (!(fabsf(alpha) < 3e38f)) F.MISC[6] = 1u; if (!(fabsf(m_run) < 3e38f)) F.MISC[6] = 1u;
#endif
        if (__any(alpha < 1.f)) {
            const float a0 = __shfl(alpha, 4 * G), a1 = __shfl(alpha, 4 * G + 1), a2 = __shfl(alpha, 4 * G + 2), a3 = __shfl(alpha, 4 * G + 3); const f32x4 av = {a0, a1, a2, a3};
#pragma unroll
            for (int c = 0; c < 32; ++c) acc[c] *= av; }
        v4u pw; pw.x = cvtpk(p0.x, p0.y); pw.y = cvtpk(p0.z, p0.w); pw.z = cvtpk(p1.x, p1.y); pw.w = cvtpk(p1.z, p1.w); const bf16x8 pf = __builtin_bit_cast(bf16x8, pw);
#pragma unroll
        for (int c = 0; c < 32; ++c) { if ((c & 3) == 0) __builtin_amdgcn_sched_barrier(0);
            const s16x4 lo = vtr(vbase + c * 32), hi2 = vtr(vbase + 16 * KSTR + c * 32);
            const bf16x8 vf = (bf16x8){lo[0], lo[1], lo[2], lo[3], hi2[0], hi2[1], hi2[2], hi2[3]};
            acc[c] = __builtin_amdgcn_mfma_f32_16x16x32_bf16(pf, vf, acc[c], 0, 0, 0); }
        __syncthreads();
    }
#if defined(SMLA_CHK) && SMLA_CHK == 4
    { float t_ = 0.f; _Pragma("unroll") for (int c = 0; c < 32; ++c) t_ += (acc[c].x + acc[c].y) + (acc[c].z + acc[c].w); if (!(fabsf(t_) < 3e38f)) F.MISC[6] = 1u; }
#endif
    LAS float* ST = (LAS float*)L;
    LAS float* FAC = (LAS float*)(L + 1024);
    if (G == 0) { ST[(wid * 16 + l15) * 2] = m_run; ST[(wid * 16 + l15) * 2 + 1] = l_run; }
    __syncthreads();
    { const float mo = ST[((wid ^ 4) * 16 + l15) * 2], lo = ST[((wid ^ 4) * 16 + l15) * 2 + 1];
      const float mf = fmaxf(m_run, mo); const float e_me = __builtin_amdgcn_exp2f((m_run - mf) * C), e_ot = __builtin_amdgcn_exp2f((mo - mf) * C);
      const float fac = e_me / (l_run * e_me + lo * e_ot);
      if (G == 0) FAC[wid * 16 + l15] = fac; }
    __syncthreads();
    { const f32x4 fv = {FAC[wid * 16 + 4 * G], FAC[wid * 16 + 4 * G + 1], FAC[wid * 16 + 4 * G + 2], FAC[wid * 16 + 4 * G + 3]};
#pragma unroll
      for (int c = 0; c < 32; ++c) acc[c] *= fv; }
    __syncthreads();
    LAS f32x4* XB = (LAS f32x4*)L;
#pragma unroll
    for (int half = 0; half < 2; ++half) {
        if (kh == 1) {
#pragma unroll
            for (int c = 0; c < 16; ++c) XB[(rg * 16 + c) * 64 + lane] = acc[half * 16 + c]; }
        __syncthreads();
        if (kh == 0) {
#pragma unroll
            for (int c = 0; c < 16; ++c) acc[half * 16 + c] += XB[(rg * 16 + c) * 64 + lane]; }
        __syncthreads();
    }
#if defined(SMLA_CHK) && SMLA_CHK == 5
    if (kh == 0) { float t_ = 0.f; _Pragma("unroll") for (int c = 0; c < 32; ++c) t_ += (acc[c].x + acc[c].y) + (acc[c].z + acc[c].w); if (!(fabsf(t_) < 3e38f)) F.MISC[6] = 1u; }
#endif
    if (kh == 0) {
#pragma unroll
        for (int c = 0; c < 32; ++c) {
            LAS unsigned short* op = (LAS unsigned short*)(L + (16 * rg + 4 * G) * OSTR + (16 * c + l15) * 2);
            op[0] = (unsigned short)f2bf(acc[c].x); op[OSTR / 2] = (unsigned short)f2bf(acc[c].y); op[2 * (OSTR / 2)] = (unsigned short)f2bf(acc[c].z); op[3 * (OSTR / 2)] = (unsigned short)f2bf(acc[c].w); }
    }
    __syncthreads();
    {   const int hh = wid >> 2, rt = (wid >> 1) & 1, cb0 = 4 * (wid & 1), hd = 2 * hp + hh;
        f32x4 d[4];
#pragma unroll
        for (int j = 0; j < 4; ++j) d[j] = (f32x4){0.f, 0.f, 0.f, 0.f};
#pragma unroll 4
        for (int ks = 0; ks < 16; ++ks) {
            const bf16x8 af = *(const LAS bf16x8*)(L + (32 * hh + 16 * rt + l15) * OSTR + (32 * ks + 8 * G) * 2);
#pragma unroll
            for (int j = 0; j < 4; ++j) { const bf16x8 bfr = *(const GAS bf16x8*)(WUVT + (size_t)(hd * 128 + 16 * (cb0 + j) + l15) * 512 + 32 * ks + 8 * G);
                d[j] = __builtin_amdgcn_mfma_f32_16x16x32_bf16(af, bfr, d[j], 0, 0, 0); } }
        const bf16* BG = (const bf16*)(F.ws + WS_BGATE); bf16* OB = (bf16*)(F.ws + WS_IQ);
#pragma unroll
        for (int j = 0; j < 4; ++j)
#pragma unroll
            for (int i = 0; i < 4; ++i) { const size_t off = (size_t)(RP + b * 32 + 16 * rt + 4 * G + i) * 1024 + hd * 128 + 16 * (cb0 + j) + l15;
#ifdef SMLA_CHK
#if SMLA_CHK == 6
                if (!(fabsf(d[j][i]) < 3e38f)) F.MISC[6] = 1u;
#endif
#if SMLA_CHK == 7
                if (!(fabsf(bf2f(BG[off])) < 3e38f)) F.MISC[6] = 1u;
#endif
                OB[off] = F.MISC[6] ? (bf16)0x7fc0 : (bf16)0;
#else
                if (!dry) OB[off] = (bf16)f2bf(d[j][i] * bf2f(BG[off]));
#endif
                }
    }
    __syncthreads();
}
}

constexpr int N_U4A = 64, N_U4 = 32 + 512;
__device__ __forceinline__ void p4_unit(Frame& F, int u, bool dry = false) {
    LAS char* L = (LAS char*)(F.lds + RING_OFF);
    const int lane = F.lane, wid = F.wave, r32 = lane & 31, hi = lane >> 5;
#ifndef P4_MASK
#define P4_MASK 7
#endif
    const bf16* AQ = (const bf16*)(F.ws + WS_AQ); const bf16* AKC = (const bf16*)(F.ws + WS_AKC); const bf16* AVC = (const bf16*)(F.ws + WS_AVC); const bf16* AG = (const bf16*)(F.ws + WS_AGATE);
    if (u < 32) { if (!(P4_MASK & 2)) return;
        const int b = u >> 1, g = u & 1, head = 4 * g + (wid & 3); const int row0 = RP + b * 32;
        const size_t qoff = (size_t)row0 * 1024 + head * 128;
        att::attn_body<false, true>(AQ + qoff + (size_t)r32 * 1024, nullptr, (const float*)(F.ws + WS_BIAS_S) + (size_t)(b * 32 + r32) * LSP, 1 << 30,
                                    AKC + (size_t)(RP + b * LSP) * 256 + g * 128, AVC + (size_t)(RP + b * LSP) * 256 + g * 128, 256, nullptr, 33, SC_DSA,
                                    (bf16*)(F.ws + WS_AQ) + qoff, AG + qoff, wid < 4 && !dry, L);
        return; }
    u -= 32;
    const int r = 7 - (u >> 6), v = u & 63;
    if (v < 32) { if (!(P4_MASK & 4)) return;
        const int b = v >> 3, h = v & 7, qb = r; const int row0 = b * 2048 + qb * 256 + wid * 32;
        const bf16* QN = (const bf16*)((unsigned char*)F.out + DO_QN); const bf16* QR = (const bf16*)((unsigned char*)F.out + DO_QR);
        const bf16* KN = (const bf16*)((unsigned char*)F.out + DO_KN); const bf16* VV = (const bf16*)((unsigned char*)F.out + DO_V); const bf16* KRP = (const bf16*)(F.ws + WS_KRP);
        const size_t qoff = (size_t)row0 * 1024 + h * 128;
        att::attn_body<true, false>(QN + qoff + (size_t)r32 * 1024, QR + (size_t)(row0 + r32) * 512 + h * 64, nullptr, 4 * qb + (wid >> 1),
                                    KN + (size_t)(b * 2048) * 1024 + h * 128, VV + (size_t)(b * 2048) * 1024 + h * 128, 1024, KRP + (size_t)(b * 2048) * 64, 4 * (qb + 1), SC_MLA,
                                    (bf16*)(F.ws + WS_IQ) + qoff, (const bf16*)(F.ws + WS_BGATE) + qoff, !dry, L);
    } else { if (!(P4_MASK & 2)) return;
        const int w2 = v - 32, c = 4 * r + 3 - (w2 >> 3), b = (w2 >> 1) & 3, g = w2 & 1, head = 4 * g + (wid & 3), sub = wid >> 2;
        const int row0 = b * 2048 + c * 64 + sub * 32; const size_t qoff = (size_t)row0 * 1024 + head * 128;
        const float* bias = (const float*)(F.ws + WS_BIAS_P) + tri_off(b, c) + (size_t)(sub * 32 + r32) * tri_stride(c);
        att::attn_body<false, true>(AQ + qoff + (size_t)r32 * 1024, nullptr, bias, 1 << 30,
                                    AKC + (size_t)(b * 2048) * 256 + g * 128, AVC + (size_t)(b * 2048) * 256 + g * 128, 256, nullptr, c + 1, SC_DSA,
                                    (bf16*)(F.ws + WS_AQ) + qoff, AG + qoff, !dry, L);
    }
    (void)hi;
}
constexpr int N_U3 = 16 + 256;
__device__ __forceinline__ void p3_unit(Frame& F, int u, int part = 3) {
    if (u < 16) { idx_unit(F, 1, u, 0, 0, part); return; }
    const int v = u - 16, c = 31 - (v >> 3), b = (v >> 1) & 3, sub = v & 1;
    idx_unit(F, 0, b, c, sub, part);
}
__device__ __forceinline__ int dequeue(Frame& F, gu32* ctr) {
    if (F.tid == 0) F.MISC[4] = __hip_atomic_fetch_add(ctr, 1u, RLX_AGENT);
    __syncthreads();
    const int u = (int)F.MISC[4];
    __syncthreads();
    return u;
}

__device__ __forceinline__ void p7_final(Frame& F) {
    const int gw = F.vcu * NWAVES + F.wave, NGW = F.G * NWAVES; const GAS f32x4* gr = (const GAS f32x4*)F.in[I_FG] + F.lane;
    for (int m = gw; m < RT; m += NGW) {
        GAS f32x4* p = (GAS f32x4*)(F.out + (size_t)m * DM) + F.lane;
        f32x4 v[8]; float s = 0.f;
#pragma unroll
        for (int j = 0; j < 8; ++j) { v[j] = p[64 * j]; s += (v[j].x * v[j].x + v[j].y * v[j].y) + (v[j].z * v[j].z + v[j].w * v[j].w); }
        const float rs = 1.0f / sqrtf(wave_sum(s) * (1.f / DM) + EPS);
#pragma unroll
        for (int j = 0; j < 8; ++j) p[64 * j] = v[j] * rs * gr[64 * j];
    }
}

#ifndef MK_N_LAUNCHES
#define MK_N_LAUNCHES 1
#endif
constexpr int N_PHASES = 8;
struct Args { const float* in[18]; float* out; unsigned char* ws; int ph_lo, ph_hi; };
__global__ void __launch_bounds__(NWAVES * 64, 2) mk_fwd(Args args) {
    extern __shared__ __attribute__((aligned(16))) unsigned char lds[];
    Frame F;
    F.lds = (LAS unsigned char*)lds; F.MISC = (volatile LAS unsigned*)(F.lds + MISC_OFF);
    F.tid = threadIdx.x; F.lane = F.tid & 63; F.wave = __builtin_amdgcn_readfirstlane(F.tid >> 6);
    F.G = gridDim.x; { const int bx = blockIdx.x; F.vcu = (F.G % 8 == 0) ? (bx % 8) * (F.G / 8) + bx / 8 : bx; }
    F.ws = args.ws; F.out = args.out; F.ctl = (gu32*)(args.ws + WS_CTL);
#pragma unroll
    for (int i = 0; i < 18; ++i) F.in[i] = args.in[i];
    for (int u = F.tid; u < (LDS_BYTES - LDSCTL_OFF) / 4; u += NWAVES * 64) ((LAS unsigned*)(F.lds + LDSCTL_OFF))[u] = 0u;
    __syncthreads();
    const int lo = args.ph_lo, hi = args.ph_hi;
    XcdBarrier bar; bar.bar = (unsigned*)(F.ctl + CW_BAR); bar.x = 0; bar.st = nullptr;
    if (hi - lo > 1) bar = xcd_barrier_post((unsigned*)(F.ctl + CW_BAR), F.MISC + 8);
#ifndef PH_MASK
#define PH_MASK 255
#endif
#define IN(k) (((PH_MASK >> (k)) & 1) && lo <= (k) && (k) < hi)
#define SEAM(k) do { if (IN(k) && IN((k) + 1)) xcd_barrier(bar); } while (0)
#ifndef REP_PHASE
#define REP_PHASE -1
#endif


#define BODY0() do { p0_prologue(F); } while (0)
#define BODY1() do { pg8::Gemm g{(const bf16*)((unsigned char*)F.out + DO_XN), (const bf16*)(F.ws + WS_WIN_T), RT, PROJP, DM}; pg8::StaticOrder S; S.init(RT, PROJP, F.G, (int)blockIdx.x); \
        EpiInProj E{F.out, F.ws}; pg8::gemm_phase<EpiInProj, pg8::StaticOrder, true, true>(F.lds + RING_OFF, g, S, E); } while (0)
#define BODY2() do { pg8::Gemm g{(const bf16*)(F.ws + WS_CQ), (const bf16*)(F.ws + WS_WUQ_T), 0, 0, 512}; OrderP2 S{F.G, (int)blockIdx.x}; \
        EpiP2 E{F.out, F.ws}; pg8::gemm_phase<EpiP2, OrderP2, true, true>(F.lds + RING_OFF, g, S, E); } while (0)
#ifndef P3_PART
#define P3_PART 3
#endif
#define BODY3(qoff) do { for (;;) { const int u = dequeue(F, F.ctl + CW_Q3 + (qoff)); if (u >= N_U3) break; p3_unit(F, u, (qoff) ? P3_PART : 3); } } while (0)
#define BODY5() do { pg8::Gemm g{(const bf16*)(F.ws + WS_AQ), (const bf16*)(F.ws + WS_WOA_T), 0, 0, 1024}; OrderP5 S{F.G, (int)blockIdx.x}; \
        EpiP5 E{F.out, F.ws}; pg8::gemm_phase<EpiP5, OrderP5, true, true>(F.lds + RING_OFF, g, S, E); \
        for (int t_ = F.vcu; t_ < 64; t_ += F.G) sg::p5_sample(F, t_ >> 4, t_ & 15); } while (0)
#define BODY6() do { pg8::Gemm g{(const bf16*)(F.ws + WS_AGATE), (const bf16*)(F.ws + WS_WOUT_T), RP, DM, DM}; pg8::StaticOrder S; S.init(RP, DM, F.G, (int)blockIdx.x); \
        EpiP6 E{F.out, F.ws, F.in[I_XP], F.in[I_XS]}; pg8::gemm_phase<EpiP6, pg8::StaticOrder, true, true>(F.lds + RING_OFF, g, S, E); \
        for (int t_ = F.vcu; t_ < 64; t_ += F.G) sg::p6_sample(F, t_ >> 4, t_ & 15); } while (0)
#define REPSEAM() do { if (hi - lo > 1) xcd_barrier(bar); } while (0)
    if (IN(0)) { BODY0(); SEAM(0); }
#if REP_PHASE == 0
    if (IN(0)) { BODY0(); REPSEAM(); }
#endif
    if (IN(1)) { BODY1(); SEAM(1); }
#if REP_PHASE == 1
    if (IN(1)) { BODY1(); REPSEAM(); }
#endif
    if (IN(2)) { BODY2(); SEAM(2); }
#if REP_PHASE == 2
    if (IN(2)) { BODY2(); REPSEAM(); }
#endif
#if REP_PHASE == 3
    if (IN(3)) { BODY3(16); REPSEAM(); }
#endif
    if (IN(3)) { ckv_norm(F); BODY3(0); SEAM(3); }
#if REP_PHASE == 4
    if (IN(4)) {
#ifndef P4_PART
#define P4_PART 3
#endif
        if (P4_PART & 1) for (;;) { const int u = dequeue(F, F.ctl + CW_Q4A + 16); if (u >= N_U4A) break; smla::unit(F, u >> 2, u & 3, true); }
        if (P4_PART & 2) for (;;) { const int u = dequeue(F, F.ctl + CW_Q4 + 16); if (u >= N_U4) break; p4_unit(F, u, true); }
        REPSEAM();
    }
#endif
    if (IN(4)) {
        for (;;) { const int u = dequeue(F, F.ctl + CW_Q4A); if (u >= N_U4A) break; smla::unit(F, u >> 2, u & 3); }
        for (;;) { const int u = dequeue(F, F.ctl + CW_Q4); if (u >= N_U4) break; p4_unit(F, u); }
        SEAM(4);
    }
    if (IN(5)) { BODY5(); SEAM(5); }
#if REP_PHASE == 5
    if (IN(5)) { BODY5(); REPSEAM(); }
#endif
    if (IN(6)) { BODY6(); SEAM(6); }
#if REP_PHASE == 6
    if (IN(6)) { BODY6(); REPSEAM(); }
#endif
    if (IN(7)) p7_final(F);

#undef IN
#undef SEAM
}

extern "C" void kernel_launch(void* const* d_in, const int* in_sizes, int n_in, void* d_out, int out_size, void* d_ws, size_t ws_size, hipStream_t stream) {
    static int grid = 0;
    if (grid == 0) {
        if (n_in != 18 || out_size != (int)O_END || ws_size < WS_END) { fprintf(stderr, "kernel_launch: unexpected shapes: n_in %d out %d ws %zu (need %zu)\n", n_in, out_size, ws_size, (size_t)WS_END); grid = -1; return; }
        int dev = 0, cus = 0;
        if (hipGetDevice(&dev) != hipSuccess || hipDeviceGetAttribute(&cus, hipDeviceAttributeMultiprocessorCount, dev) != hipSuccess) { grid = -1; return; }
        if (hipFuncSetAttribute((const void*)mk_fwd, hipFuncAttributeMaxDynamicSharedMemorySize, LDS_BYTES) != hipSuccess) { fprintf(stderr, "kernel_launch: hipFuncSetAttribute failed\n"); grid = -1; return; }
        int per_cu = 0;
        if (hipOccupancyMaxActiveBlocksPerMultiprocessor(&per_cu, (const void*)mk_fwd, NWAVES * 64, LDS_BYTES) != hipSuccess || per_cu < 1) fprintf(stderr, "kernel_launch: occupancy query says %d blocks per CU\n", per_cu);
        (void)hipGetLastError();
        grid = cus;
    }
    if (grid < 0) return;
    (void)hipMemsetAsync((char*)d_ws + WS_CTL, 0, CTL_ZERO_BYTES, stream);
    Args a{};
    for (int i = 0; i < 18; ++i) a.in[i] = (const float*)d_in[i];
    a.out = (float*)d_out; a.ws = (unsigned char*)d_ws;
#if MK_N_LAUNCHES == 1
    a.ph_lo = 0; a.ph_hi = N_PHASES;
    hipLaunchKernelGGL(mk_fwd, dim3(grid), dim3(NWAVES * 64), LDS_BYTES, stream, a);
#else
    for (int p = 0; p < N_PHASES; ++p) { a.ph_lo = p; a.ph_hi = p + 1; hipLaunchKernelGGL(mk_fwd, dim3(grid), dim3(NWAVES * 64), LDS_BYTES, stream, a); }
#endif
    const hipError_t le = hipPeekAtLastError();
    if (le != hipSuccess) fprintf(stderr, "kernel_launch: launch failed: %s\n", hipGetErrorName(le));
}
```
